# Optimizing an MI355X kernel written in HIP

```python
import jax, jax.numpy as jnp
from jax import lax
import numpy as np

D_MODEL = 2048
BATCH = 1
SEQ = 16384
DEPTH = 4
DEC_BATCH = 32
DEC_SEQ = 16
PAST_LEN = 1024

CHUNK = 64
N_MIXERS = 3
N_A_LAYERS = (DEPTH + 2) // 3
N_B_LAYERS = (DEPTH + 1) // 3
N_C_LAYERS = DEPTH // 3
NORM_EPS = 1e-6

A_WIDTH = 2 * D_MODEL
A_GROUPS = 16
A_GROUP_DIM = A_WIDTH // A_GROUPS
A_CHUNK = 128

B_D_INNER = 2 * D_MODEL
B_HEAD_DIM = 64
B_HEADS = B_D_INNER // B_HEAD_DIM
B_GROUPS = 8
B_HEADS_PER_GROUP = B_HEADS // B_GROUPS
B_STATE = 128
B_CONV = 4
B_CONV_DIM = B_D_INNER + 2 * B_GROUPS * B_STATE
B_IN_DIM = B_D_INNER + B_CONV_DIM + B_HEADS
B_SCAN_CHUNK = CHUNK

C_HEADS = 16
C_HEAD_DIM = D_MODEL // C_HEADS
C_WIDTH = C_HEADS * C_HEAD_DIM
C_BLOCK = 128

kernel_name = 'hybrid_gmlp_ssd_stickbreak_stream_step'


def rms_norm(x, w):
    xf = x.astype(jnp.float32)
    y = xf * lax.rsqrt(jnp.mean(xf * xf, axis=-1, keepdims=True) + NORM_EPS)
    return (y * w.astype(jnp.float32)).astype(x.dtype)


def gmlp_mixer(h, w_in, ln_g, ln_b, w_s, b_s, w_out):
    bsz, L, _ = h.shape
    u, v, z = jnp.split(h @ w_in, 3, axis=-1)
    u = jax.nn.gelu(u, approximate=False)
    vf = jax.nn.gelu(v, approximate=False).astype(jnp.float32)
    vc = vf - jnp.mean(vf, axis=-1, keepdims=True)
    var = jnp.mean(vc * vc, axis=-1, keepdims=True)
    v = (vc * lax.rsqrt(var + NORM_EPS) * ln_g + ln_b).astype(h.dtype)
    lc = min(L, A_CHUNK)
    pos = jnp.arange(lc)
    mask = (pos[None, :] // CHUNK) <= (pos[:, None] // CHUNK)
    w_pos = jnp.where(mask[None], w_s[:, :lc, :lc], 0.0)
    vg = v.reshape(bsz, L // lc, lc, A_GROUPS, A_GROUP_DIM)
    s = jnp.einsum('gts,bcsgk->bctgk', w_pos, vg) + b_s[:, :lc].T[None, None, :, :, None]
    y = u * s.reshape(bsz, L, A_WIDTH) * jax.nn.silu(z)
    return y @ w_out, v


def ssd_scan(x, dt, a, bm, cm, s0):
    bsz, L = x.shape[:2]
    lc = min(L, B_SCAN_CHUNK)
    nc = L // lc

    def to_chunks(t):
        return jnp.moveaxis(t.reshape(bsz, nc, lc, *t.shape[2:]), 1, 0)

    tri = jnp.tril(jnp.ones((lc, lc), dtype=bool))

    def step(s, inp):
        xc, dtc, bc, cc = inp
        cum = jnp.cumsum(dtc * a, axis=1)
        seg = cum[:, :, None] - cum[:, None, :]
        decay = jnp.exp(jnp.where(tri[None, :, :, None, None], seg, -jnp.inf))
        cb = jnp.einsum('btgn,bsgn->btsg', cc, bc)
        y = jnp.einsum('btsg,btsgr,bsgr,bsgrp->btgrp', cb, decay, dtc, xc)
        y = y + jnp.einsum('btgn,bgrpn,btgr->btgrp', cc, s, jnp.exp(cum))
        w_end = jnp.exp(cum[:, -1:] - cum) * dtc
        s = s * jnp.exp(cum[:, -1])[..., None, None] + jnp.einsum('bsgn,bsgr,bsgrp->bgrpn', bc, w_end, xc)
        return s, y

    s_final, ys = lax.scan(step, s0, (to_chunks(x), to_chunks(dt), to_chunks(bm), to_chunks(cm)))
    y = jnp.moveaxis(ys, 0, 1).reshape(x.shape)
    return y, s_final


def mamba_mixer(h, ssm_state, conv_state, w_in, conv_w, conv_b, dt_bias, a_log, d_skip, norm_w, w_out):
    bsz, L, _ = h.shape
    proj = h @ w_in
    z = proj[..., :B_D_INNER]
    xbc = proj[..., B_D_INNER:B_D_INNER + B_CONV_DIM]
    dt = proj[..., B_D_INNER + B_CONV_DIM:]
    xpad = jnp.concatenate([conv_state.astype(xbc.dtype), xbc], axis=1)
    new_conv = xpad[:, -(B_CONV - 1):]
    conv = conv_b
    for k in range(B_CONV):
        conv = conv + xpad[:, k:k + L] * conv_w[k]
    xbc = jax.nn.silu(conv)
    x = xbc[..., :B_D_INNER]
    bm = xbc[..., B_D_INNER:B_D_INNER + B_GROUPS * B_STATE]
    cm = xbc[..., B_D_INNER + B_GROUPS * B_STATE:]
    f32 = jnp.float32
    dt = jax.nn.softplus(dt.astype(f32) + dt_bias.astype(f32))
    a = -jnp.exp(a_log.astype(f32)).reshape(B_GROUPS, B_HEADS_PER_GROUP)
    xh = x.astype(f32).reshape(bsz, L, B_GROUPS, B_HEADS_PER_GROUP, B_HEAD_DIM)
    y, s_new = ssd_scan(
        xh,
        dt.reshape(bsz, L, B_GROUPS, B_HEADS_PER_GROUP),
        a,
        bm.astype(f32).reshape(bsz, L, B_GROUPS, B_STATE),
        cm.astype(f32).reshape(bsz, L, B_GROUPS, B_STATE),
        ssm_state.astype(f32).reshape(bsz, B_GROUPS, B_HEADS_PER_GROUP, B_HEAD_DIM, B_STATE))
    y = y + d_skip.astype(f32).reshape(B_GROUPS, B_HEADS_PER_GROUP)[..., None] * xh
    y = y.reshape(bsz, L, B_D_INNER) * jax.nn.silu(z.astype(f32))
    yg = y.reshape(bsz, L, B_GROUPS, B_D_INNER // B_GROUPS)
    yg = yg * lax.rsqrt(jnp.mean(yg * yg, axis=-1, keepdims=True) + NORM_EPS)
    y = (yg.reshape(bsz, L, B_D_INNER) * norm_w.astype(f32)).astype(h.dtype)
    s_new = s_new.reshape(bsz, B_HEADS, B_HEAD_DIM, B_STATE).astype(h.dtype)
    return y @ w_out, s_new, new_conv


def sb_attend(q, k, v, q_pos, k_pos):
    z = jnp.einsum('bhtd,bhsd->bhts', q.astype(jnp.float32), k.astype(jnp.float32)) * (C_HEAD_DIM ** -0.5)
    visible = k_pos[None, :] < q_pos[:, None]
    log_keep = jnp.where(visible, jax.nn.log_sigmoid(-z), 0.0)
    log_surv = lax.cumsum(log_keep, axis=3, reverse=True) - log_keep
    w = jnp.where(visible, jnp.exp(jax.nn.log_sigmoid(z) + log_surv), 0.0)
    return jnp.einsum('bhts,bhsd->bhtd', w, v.astype(jnp.float32)).astype(q.dtype)


def sb_mixer(h, k_past, v_past, w_in, w_out):
    bsz, L, _ = h.shape
    q, k, v, z = jnp.split(h @ w_in, 4, axis=-1)

    def heads(t):
        return t.reshape(bsz, L, C_HEADS, C_HEAD_DIM).transpose(0, 2, 1, 3)

    q, k, v = heads(q), heads(k), heads(v)
    past = k_past.shape[2]
    k_all = jnp.concatenate([k_past.astype(k.dtype), k], axis=2)
    v_all = jnp.concatenate([v_past.astype(v.dtype), v], axis=2)
    k_pos = jnp.arange(past + L)
    blk = min(L, C_BLOCK)
    nb = L // blk
    qb = jnp.moveaxis(q.reshape(bsz, C_HEADS, nb, blk, C_HEAD_DIM), 2, 0)
    starts = past + jnp.arange(nb) * blk
    o = lax.map(lambda a: sb_attend(a[0], k_all, v_all, a[1] + jnp.arange(blk), k_pos), (qb, starts))
    o = jnp.moveaxis(o, 0, 2).reshape(bsz, C_HEADS, L, C_HEAD_DIM).transpose(0, 2, 1, 3).reshape(bsz, L, C_WIDTH)
    y = (o * jax.nn.silu(z)) @ w_out
    return y, k, v


def setup_inputs(seed: int = 0) -> dict:
    key = jax.random.key(seed)
    ks = jax.random.split(key, 26)
    f32 = jnp.float32

    def nrm(k, shape, scale):
        return jax.random.normal(k, shape, f32) * scale

    dt0 = jnp.exp(jax.random.uniform(ks[16], (N_B_LAYERS, B_HEADS), f32, np.log(1e-3), np.log(1e-1)))
    return {
        'x_prompt': nrm(ks[0], (BATCH, SEQ, D_MODEL), 1.0),
        'x_sample': nrm(ks[1], (DEC_BATCH, DEC_SEQ, D_MODEL), 1.0),
        'state_ssm': nrm(ks[2], (N_B_LAYERS, DEC_BATCH, B_HEADS, B_HEAD_DIM, B_STATE), 0.5),
        'state_conv': nrm(ks[3], (N_B_LAYERS, DEC_BATCH, B_CONV - 1, B_CONV_DIM), 1.0),
        'cache_k': nrm(ks[4], (N_C_LAYERS, DEC_BATCH, C_HEADS, PAST_LEN, C_HEAD_DIM), 1.0),
        'cache_v': nrm(ks[5], (N_C_LAYERS, DEC_BATCH, C_HEADS, PAST_LEN, C_HEAD_DIM), 1.0),
        'norm_w': 1.0 + nrm(ks[6], (DEPTH, D_MODEL), 0.02),
        'final_norm_w': 1.0 + nrm(ks[7], (D_MODEL,), 0.02),
        'a_w_in': nrm(ks[8], (N_A_LAYERS, D_MODEL, 3 * A_WIDTH), D_MODEL ** -0.5),
        'a_ln_g': 1.0 + nrm(ks[9], (N_A_LAYERS, A_WIDTH), 0.02),
        'a_ln_b': nrm(ks[10], (N_A_LAYERS, A_WIDTH), 0.02),
        'a_w_s': nrm(ks[11], (N_A_LAYERS, A_GROUPS, A_CHUNK, A_CHUNK), A_CHUNK ** -0.5),
        'a_b_s': 1.0 + nrm(ks[12], (N_A_LAYERS, A_GROUPS, A_CHUNK), 0.01),
        'a_w_out': nrm(ks[13], (N_A_LAYERS, A_WIDTH, D_MODEL), A_WIDTH ** -0.5),
        'b_w_in': nrm(ks[14], (N_B_LAYERS, D_MODEL, B_IN_DIM), D_MODEL ** -0.5),
        'b_conv_w': nrm(ks[15], (N_B_LAYERS, B_CONV, B_CONV_DIM), B_CONV ** -0.5),
        'b_conv_b': nrm(ks[17], (N_B_LAYERS, B_CONV_DIM), 0.02),
        'b_dt_bias': dt0 + jnp.log(-jnp.expm1(-dt0)),
        'b_a_log': jnp.log(jax.random.uniform(ks[18], (N_B_LAYERS, B_HEADS), f32, 1.0, 16.0)),
        'b_d': 1.0 + nrm(ks[19], (N_B_LAYERS, B_HEADS), 0.02),
        'b_norm_w': 1.0 + nrm(ks[20], (N_B_LAYERS, B_D_INNER), 0.02),
        'b_w_out': nrm(ks[21], (N_B_LAYERS, B_D_INNER, D_MODEL), B_D_INNER ** -0.5),
        'c_w_in': nrm(ks[22], (N_C_LAYERS, D_MODEL, 4 * C_WIDTH), D_MODEL ** -0.5),
        'c_w_out': nrm(ks[23], (N_C_LAYERS, C_WIDTH, D_MODEL), C_WIDTH ** -0.5),
    }


def reference(x_prompt, x_sample, state_ssm, state_conv, cache_k, cache_v,
              norm_w, final_norm_w,
              a_w_in, a_ln_g, a_ln_b, a_w_s, a_b_s, a_w_out,
              b_w_in, b_conv_w, b_conv_b, b_dt_bias, b_a_log, b_d, b_norm_w, b_w_out,
              c_w_in, c_w_out):
    xp, xs = x_prompt, x_sample
    gmlp_v_s, ssm_p, conv_p, ssm_s, conv_s = [], [], [], [], []
    k_p, v_p, k_s, v_s = [], [], [], []
    bp = xp.shape[0]
    for i in range(DEPTH):
        kind, j = i % N_MIXERS, i // N_MIXERS
        hp = rms_norm(xp, norm_w[i])
        hs = rms_norm(xs, norm_w[i])
        if kind == 0:
            a_par = (a_w_in[j], a_ln_g[j], a_ln_b[j], a_w_s[j], a_b_s[j], a_w_out[j])
            dp, _ = gmlp_mixer(hp, *a_par)
            ds, v_new = gmlp_mixer(hs, *a_par)
            gmlp_v_s.append(v_new)
        elif kind == 1:
            b_par = (b_w_in[j], b_conv_w[j], b_conv_b[j], b_dt_bias[j], b_a_log[j], b_d[j], b_norm_w[j], b_w_out[j])
            s0 = jnp.zeros((bp, B_HEADS, B_HEAD_DIM, B_STATE), xp.dtype)
            c0 = jnp.zeros((bp, B_CONV - 1, B_CONV_DIM), xp.dtype)
            dp, s1, c1 = mamba_mixer(hp, s0, c0, *b_par)
            ds, s2, c2 = mamba_mixer(hs, state_ssm[j], state_conv[j], *b_par)
            ssm_p.append(s1)
            conv_p.append(c1)
            ssm_s.append(s2)
            conv_s.append(c2)
        else:
            empty = jnp.zeros((bp, C_HEADS, 0, C_HEAD_DIM), xp.dtype)
            dp, k1, v1 = sb_mixer(hp, empty, empty, c_w_in[j], c_w_out[j])
            ds, k2, v2 = sb_mixer(hs, cache_k[j], cache_v[j], c_w_in[j], c_w_out[j])
            k_p.append(k1)
            v_p.append(v1)
            k_s.append(k2)
            v_s.append(v2)
        xp = xp + dp
        xs = xs + ds
    y_prompt = rms_norm(xp, final_norm_w)
    y_sample = rms_norm(xs, final_norm_w)
    return (y_prompt, y_sample, jnp.stack(gmlp_v_s), jnp.stack(ssm_p), jnp.stack(conv_p),
            jnp.stack(ssm_s), jnp.stack(conv_s), jnp.stack(k_p), jnp.stack(v_p),
            jnp.stack(k_s), jnp.stack(v_s))
```

```cpp
#include <hip/hip_runtime.h>
#include <cstdio>
#include <cstdint>
namespace pg8 {
#define PG8_LAS __attribute__((address_space(3)))
typedef unsigned short bf16_t;
typedef short bf16x8 __attribute__((ext_vector_type(8)));
typedef float f32x4 __attribute__((ext_vector_type(4)));
typedef unsigned u32x4 __attribute__((ext_vector_type(4)));
constexpr int BM = 256, BK = 64, HALF = 128, HTB = HALF * BK * 2  , STAGE_BYTES = 8 * HTB, NXCD = 8, WGM = 8;

__host__ __device__ __forceinline__ int lds_byte(int r, int c) { const int st = (r >> 4) * 2 + (c >> 5), rr = r & 15, cc = c & 31, ob = rr * 64 + cc * 2; return st * 1024 + (ob ^ (((ob >> 9) & 1) << 5)); }
__host__ __device__ __forceinline__ void stage_rc(int b, int& R, int& C) { const int st = b / 1024, sb = b % 1024, swz = sb ^ (((sb >> 9) & 1) << 5); R = (st >> 1) * 16 + swz / 64; C = (st & 1) * 32 + (swz % 64) / 2; }
__host__ __device__ __forceinline__ int perm32(int rho) { const int n = rho >> 4, i = rho & 15; return 8 * (i >> 2) + 4 * n + (i & 3); }

struct Unit { int pm, pn, ko, nt; };
struct Gemm { const bf16_t* A; const bf16_t* Bt; int M, N, K; };

struct StaticOrder {
    int nM, nN, nwg, G, c, ntk;
    __host__ __device__ void init(int M, int N, int G_, int c_, int K) { nM = M / BM; nN = N / BM; nwg = nM * nN; G = G_; c = c_; ntk = K / BK; }
    __host__ __device__ bool next(int i, Unit& u) const {
        const long L = (long)i * G + c; if (L >= nwg) return false;
        int wgid = (int)L; { const int q = nwg / NXCD, r = nwg % NXCD, xcd = wgid % NXCD, off = wgid / NXCD; wgid = (xcd < r ? xcd * (q + 1) : r * (q + 1) + (xcd - r) * q) + off; }
        const int nig = WGM * nN, gid = wgid / nig, fm = gid * WGM, gsz = (nM - fm) < WGM ? (nM - fm) : WGM;
        u.pm = fm + ((wgid % nig) % gsz); u.pn = (wgid % nig) / gsz; u.ko = 0; u.nt = ntk; return true;
    }
    __device__ __forceinline__ void a_ready(const Unit&) const {}
    __device__ __forceinline__ void done(const Unit&) const {}
};
struct OutProjOrder {
    StaticOrder so; int nfull, nitems, nsplit, nts, nN, pm0;
    __host__ __device__ void init(int Mfull, int Msmp, int N, int K, int nsplit_, int G_, int c_) { so.init(Mfull, N, G_, c_, K); nfull = so.nwg; nN = N / BM; nsplit = nsplit_; nitems = (Msmp / BM) * nN * nsplit; nts = K / BK / nsplit; pm0 = Mfull / BM; }
    __host__ __device__ bool next(int i, Unit& u) const {
        const long L = (long)i * so.G + so.c;
        if (L < nfull) return so.next(i, u);
        const int it = (int)(L - nfull); if (it >= nitems) return false;
        const int ks = it % nsplit, r = it / nsplit; u.pn = r % nN; u.pm = pm0 + r / nN; u.ko = ks * nts * BK; u.nt = nts; return true;
    }
    __device__ __forceinline__ void a_ready(const Unit&) const {}
    __device__ __forceinline__ void done(const Unit&) const {}
};

struct SameTileOrder { StaticOrder so;
    __host__ __device__ bool next(int i, Unit& u) const { const bool ok = so.next(i, u); u.pm = 0; u.pn = 0; return ok; }
    __device__ __forceinline__ void a_ready(const Unit&) const {}
    __device__ __forceinline__ void done(const Unit&) const {}
};
__device__ __forceinline__ unsigned cvt_pk_bf16(float lo, float hi) { unsigned r; asm volatile("v_cvt_pk_bf16_f32 %0, %1, %2" : "=v"(r) : "v"(lo), "v"(hi)); return r; }
typedef float f32x2 __attribute__((ext_vector_type(2)));
__device__ __forceinline__ f32x2 gelu_pk(f32x2 v) {
    const f32x2 av = __builtin_elementwise_abs(v), d = av * 0.2316418882f + 1.0f;
    f32x2 t; t.x = __builtin_amdgcn_rcpf(d.x); t.y = __builtin_amdgcn_rcpf(d.y);
    f32x2 q = t * 0.5307027145f + (-0.7265760135f); q = q * t + 0.7107068705f; q = q * t + (-0.142248368f); q = q * t + 0.127414796f; q = q * t;
    const f32x2 s = (v * v) * (-0.72134752044f);
    f32x2 e; e.x = __builtin_amdgcn_exp2f(s.x); e.y = __builtin_amdgcn_exp2f(s.y);
    const f32x2 m = v * (q * e), r = v - m;
    f32x2 o; o.x = v.x < 0.f ? m.x : r.x; o.y = v.y < 0.f ? m.y : r.y; return o;
}
typedef unsigned u32x2 __attribute__((ext_vector_type(2)));
__device__ __forceinline__ float silu_f(float v) { return v * __builtin_amdgcn_rcpf(1.0f + __builtin_amdgcn_exp2f(-1.44269504f * v)); }
__device__ __forceinline__ f32x4 silu4(f32x4 v) { f32x4 o; o[0] = silu_f(v[0]); o[1] = silu_f(v[1]); o[2] = silu_f(v[2]); o[3] = silu_f(v[3]); return o; }
__device__ __forceinline__ f32x4 gelu4(f32x4 v) { const f32x2 a = gelu_pk((f32x2){v[0], v[1]}), b = gelu_pk((f32x2){v[2], v[3]}); return (f32x4){a.x, a.y, b.x, b.y}; }
__device__ __forceinline__ float softplus_f(float x) { const float e = __expf(-fabsf(x)); const float l = e < 1e-3f ? e * (1.0f - e * (0.5f - e * 0.33333334f)) : __logf(1.0f + e); return fmaxf(x, 0.f) + l; }
__device__ __forceinline__ u32x4 pack8(f32x4 v0, f32x4 v1) { u32x4 w; w.x = cvt_pk_bf16(v0[0], v0[1]); w.y = cvt_pk_bf16(v0[2], v0[3]); w.z = cvt_pk_bf16(v1[0], v1[1]); w.w = cvt_pk_bf16(v1[2], v1[3]); return w; }

struct EpiAIn {
    static constexpr bool PERM = true, AFTER_DRAIN = false;
    bf16_t* U; size_t sect_stride; float* stats; PG8_LAS unsigned char* xl; const float* rstd;
    __device__ __forceinline__ void operator()(const f32x4 (&acc)[2][2][4][2], const Unit& u, int wr, int wc, int fr, int fq) const {
        const int sect = u.pn >> 4, tl = u.pn & 15;
        bf16_t* base = U + (size_t)sect * sect_stride + tl * BM + wc * 32 + 8 * fq;
        const int row0 = u.pm * BM + wr * 64 + fr;
        if (sect != 1) {
#pragma unroll
            for (int ai = 0; ai < 2; ++ai)
#pragma unroll
                for (int m = 0; m < 4; ++m) { const int row = row0 + ai * HALF + m * 16; const float rs = rstd[row]; bf16_t* rowp = base + (size_t)row * 4096;
#pragma unroll
                    for (int bj = 0; bj < 2; ++bj) *(u32x4*)(rowp + bj * HALF) = pack8(acc[ai][bj][m][0] * rs, acc[ai][bj][m][1] * rs); }
        } else {
            PG8_LAS f32x2* P = (PG8_LAS f32x2*)xl;
#pragma unroll
            for (int ai = 0; ai < 2; ++ai)
#pragma unroll
                for (int m = 0; m < 4; ++m) { const int rl = ai * HALF + wr * 64 + m * 16 + fr; const float rs = rstd[u.pm * BM + rl]; bf16_t* rowp = base + (size_t)(u.pm * BM + rl) * 4096; float s = 0.f, q = 0.f;
#pragma unroll
                    for (int bj = 0; bj < 2; ++bj) { const f32x4 v0 = gelu4(acc[ai][bj][m][0] * rs), v1 = gelu4(acc[ai][bj][m][1] * rs);
                        s += ((v0[0] + v0[1]) + (v0[2] + v0[3])) + ((v1[0] + v1[1]) + (v1[2] + v1[3]));
                        q += ((v0[0] * v0[0] + v0[1] * v0[1]) + (v0[2] * v0[2] + v0[3] * v0[3])) + ((v1[0] * v1[0] + v1[1] * v1[1]) + (v1[2] * v1[2] + v1[3] * v1[3]));
                        *(u32x4*)(rowp + bj * HALF) = pack8(v0, v1); }
                    s += __shfl_xor(s, 16); s += __shfl_xor(s, 32); q += __shfl_xor(q, 16); q += __shfl_xor(q, 32);
                    if (fq == 0) P[rl * 4 + wc] = (f32x2){s, q}; }
            asm volatile("s_waitcnt lgkmcnt(0)" ::: "memory"); __builtin_amdgcn_s_barrier(); asm volatile("" ::: "memory");
            const int t = (wr * 4 + wc) * 64 + fq * 16 + fr;
            if (t < 256) { const f32x2 a = P[t * 4 + 0], b = P[t * 4 + 1], c = P[t * 4 + 2], d = P[t * 4 + 3];
                *(f32x2*)(stats + ((size_t)(u.pm * BM + t) * 16 + tl) * 2) = (f32x2){(a.x + b.x) + (c.x + d.x), (a.y + b.y) + (c.y + d.y)}; }
        }
    }
};

struct EpiResid {
    static constexpr bool PERM = true, AFTER_DRAIN = false;
    bf16_t* XB; int ldc; float* SSQ; PG8_LAS unsigned char* xl; float* P; int seq, msmp, kper;
    __device__ __forceinline__ void operator()(const f32x4 (&acc)[2][2][4][2], const Unit& u, int wr, int wc, int fr, int fq) const {
        const int c0 = u.pn * BM + wc * 32 + 8 * fq;
        if (u.pm * BM < seq) {
            PG8_LAS float* PL = (PG8_LAS float*)xl;
#pragma unroll
            for (int ai = 0; ai < 2; ++ai) {
                u32x4 old[4][2];
#pragma unroll
                for (int m = 0; m < 4; ++m)
#pragma unroll
                    for (int bj = 0; bj < 2; ++bj) old[m][bj] = *(const u32x4*)(XB + (size_t)(u.pm * BM + ai * HALF + wr * 64 + m * 16 + fr) * ldc + c0 + bj * HALF);
#pragma unroll
                for (int m = 0; m < 4; ++m) { const int rl = ai * HALF + wr * 64 + m * 16 + fr; bf16_t* rowp = XB + (size_t)(u.pm * BM + rl) * ldc + c0; float q = 0.f;
#pragma unroll
                    for (int bj = 0; bj < 2; ++bj) { const u32x4 o = old[m][bj];
                        f32x4 x0 = (f32x4){__uint_as_float(o.x << 16), __uint_as_float(o.x & 0xffff0000u), __uint_as_float(o.y << 16), __uint_as_float(o.y & 0xffff0000u)} + acc[ai][bj][m][0];
                        f32x4 x1 = (f32x4){__uint_as_float(o.z << 16), __uint_as_float(o.z & 0xffff0000u), __uint_as_float(o.w << 16), __uint_as_float(o.w & 0xffff0000u)} + acc[ai][bj][m][1];
                        q += ((x0[0] * x0[0] + x0[1] * x0[1]) + (x0[2] * x0[2] + x0[3] * x0[3])) + ((x1[0] * x1[0] + x1[1] * x1[1]) + (x1[2] * x1[2] + x1[3] * x1[3]));
                        *(u32x4*)(rowp + bj * HALF) = pack8(x0, x1); }
                    q += __shfl_xor(q, 16); q += __shfl_xor(q, 32);
                    if (fq == 0) PL[rl * 4 + wc] = q; } }
            asm volatile("s_waitcnt lgkmcnt(0)" ::: "memory"); __builtin_amdgcn_s_barrier(); asm volatile("" ::: "memory");
            const int t = (wr * 4 + wc) * 64 + fq * 16 + fr;
            if (t < 256) SSQ[(size_t)(u.pm * BM + t) * 8 + u.pn] = (PL[t * 4 + 0] + PL[t * 4 + 1]) + (PL[t * 4 + 2] + PL[t * 4 + 3]);
        } else {
            float* pb = P + ((size_t)(u.ko / kper) * msmp + (u.pm * BM - seq + wr * 64 + fr)) * ldc + c0;
#pragma unroll
            for (int ai = 0; ai < 2; ++ai)
#pragma unroll
                for (int m = 0; m < 4; ++m) { float* rowp = pb + (size_t)(ai * HALF + m * 16) * ldc;
#pragma unroll
                    for (int bj = 0; bj < 2; ++bj) { *(f32x4*)(rowp + bj * HALF) = acc[ai][bj][m][0]; *(f32x4*)(rowp + bj * HALF + 4) = acc[ai][bj][m][1]; } }
        }
    }
};

struct EpiBIn {
    static constexpr bool PERM = true, AFTER_DRAIN = false;
    bf16_t *ZS, *XBC; float* DT; const float* dt_bias; float *conv_p, *conv_s; const float* rstd;
    __device__ __forceinline__ void operator()(const f32x4 (&acc)[2][2][4][2], const Unit& u, int wr, int wc, int fr, int fq) const {
        const int row0 = u.pm * BM + wr * 64 + fr;
        if (u.pn < 40) {
            bf16_t* base; int ld;
            if (u.pn < 16) { base = ZS + u.pn * BM + wc * 32 + 8 * fq; ld = 4096; } else { base = XBC + (u.pn - 16) * BM + wc * 32 + 8 * fq; ld = 6144; }
            const int c0 = (u.pn - 16) * BM + wc * 32 + 8 * fq;
#pragma unroll
            for (int ai = 0; ai < 2; ++ai)
#pragma unroll
                for (int m = 0; m < 4; ++m) { const int row = row0 + ai * HALF + m * 16; const float rs = rstd[row]; bf16_t* rowp = base + (size_t)row * ld;
                    const f32x4 a0 = acc[ai][0][m][0] * rs, a1 = acc[ai][0][m][1] * rs, b0 = acc[ai][1][m][0] * rs, b1 = acc[ai][1][m][1] * rs;
                    *(u32x4*)rowp = pack8(a0, a1); *(u32x4*)(rowp + HALF) = pack8(b0, b1);
                    if (u.pn >= 16 && u.pm >= 63 && row >= 16381) {
                        float* dst = nullptr;
                        if (row < 16384) dst = conv_p + (size_t)(row - 16381) * 6144 + c0;
                        else { const int sr = row - 16384, t = sr & 15; if (t >= 13) dst = conv_s + ((size_t)(sr >> 4) * 3 + (t - 13)) * 6144 + c0; }
                        if (dst) { *(f32x4*)dst = a0; *(f32x4*)(dst + 4) = a1; *(f32x4*)(dst + HALF) = b0; *(f32x4*)(dst + HALF + 4) = b1; }
                    } }
        } else {
            if (wc < 2) {
                const int c0 = wc * 32 + 8 * fq;
                const f32x4 b0 = *(const f32x4*)(dt_bias + c0), b1 = *(const f32x4*)(dt_bias + c0 + 4);
#pragma unroll
                for (int ai = 0; ai < 2; ++ai)
#pragma unroll
                    for (int m = 0; m < 4; ++m) { const int row = row0 + ai * HALF + m * 16; const float rs = rstd[row]; float* dst = DT + (size_t)row * 64 + c0;
                        f32x4 x0 = acc[ai][0][m][0] * rs + b0, x1 = acc[ai][0][m][1] * rs + b1;
#pragma unroll
                        for (int i = 0; i < 4; ++i) { x0[i] = softplus_f(x0[i]); x1[i] = softplus_f(x1[i]); }
                        *(f32x4*)dst = x0; *(f32x4*)(dst + 4) = x1; }
            }
        }
    }
};

struct EpiCIn {
    static constexpr bool PERM = true, AFTER_DRAIN = false;
    bf16_t* Q; size_t sect_stride; float *kp, *ks; size_t kvp_stride, kvs_stride; const float* rstd;
    __device__ __forceinline__ void operator()(const f32x4 (&acc)[2][2][4][2], const Unit& u, int wr, int wc, int fr, int fq) const {
        const int sect = u.pn >> 3, row0 = u.pm * BM + wr * 64 + fr, cl = (u.pn & 7) * BM + wc * 32 + 8 * fq;
        bf16_t* base = Q + (size_t)sect * sect_stride + cl;
        if (sect == 0 || sect == 3) {
            const float sc = sect == 0 ? 0.08838834764831845f : 1.0f;
#pragma unroll
            for (int ai = 0; ai < 2; ++ai)
#pragma unroll
                for (int m = 0; m < 4; ++m) { const int row = row0 + ai * HALF + m * 16; const float rs = rstd[row] * sc; bf16_t* rowp = base + (size_t)row * 2048;
#pragma unroll
                    for (int bj = 0; bj < 2; ++bj) *(u32x4*)(rowp + bj * HALF) = pack8(acc[ai][bj][m][0] * rs, acc[ai][bj][m][1] * rs); }
        } else {
            float* op = kp + (size_t)(sect - 1) * kvp_stride; float* os = ks + (size_t)(sect - 1) * kvs_stride;
#pragma unroll
            for (int ai = 0; ai < 2; ++ai)
#pragma unroll
                for (int m = 0; m < 4; ++m) { const int row = row0 + ai * HALF + m * 16; const float rs = rstd[row]; bf16_t* rowp = base + (size_t)row * 2048;
#pragma unroll
                    for (int bj = 0; bj < 2; ++bj) { const f32x4 v0 = acc[ai][bj][m][0] * rs, v1 = acc[ai][bj][m][1] * rs;
                        *(u32x4*)(rowp + bj * HALF) = pack8(v0, v1);
                        const int c = cl + bj * HALF, hd = c >> 7, d = c & 127; float* dst;
                        if (row < 16384) dst = op + ((size_t)hd * 16384 + row) * 128 + d;
                        else { const int sr = row - 16384; dst = os + (((size_t)(sr >> 4) * 16 + hd) * 16 + (sr & 15)) * 128 + d; }
                        *(f32x4*)dst = v0; *(f32x4*)(dst + 4) = v1; } }
        }
    }
};

template <bool NL> struct EpiNullT {
    static constexpr bool PERM = true, AFTER_DRAIN = false, NOLOAD = NL;
    float* sink;
    __device__ __forceinline__ void operator()(const f32x4 (&acc)[2][2][4][2], const Unit& u, int wr, int wc, int fr, int fq) const {
        f32x4 s = (f32x4){0.f, 0.f, 0.f, 0.f};
#pragma unroll
        for (int ai = 0; ai < 2; ++ai)
#pragma unroll
            for (int bj = 0; bj < 2; ++bj)
#pragma unroll
                for (int m = 0; m < 4; ++m) { s = s + acc[ai][bj][m][0]; s = s + acc[ai][bj][m][1]; }
        const float t = (s[0] + s[1]) + (s[2] + s[3]);
        if (t == 1.2345e30f) sink[wr * 256 + wc * 64 + fq * 16 + fr] = t;
    }
};
typedef EpiNullT<false> EpiNull; typedef EpiNullT<true> EpiNullNoLoad;
template <class E, class = void> struct pg8_noload { static constexpr bool value = false; };
template <class E> struct pg8_noload<E, decltype((void)E::NOLOAD)> { static constexpr bool value = E::NOLOAD; };
template <class Epi, class Sched, bool ALIGN_EPI = false, bool SP2 = false>
__device__ __forceinline__ void gemm_phase(PG8_LAS unsigned char* lds, const Gemm g, const Sched& S, const Epi& E) {
    const int tid = threadIdx.x, wid = __builtin_amdgcn_readfirstlane(tid >> 6), lane = tid & 63, wr = wid >> 2, wc = wid & 3, fr = lane & 15, fq = lane >> 4;
    const int K = g.K;
    unsigned voffA[2], voffB[2];
#pragma unroll
    for (int i = 0; i < 2; ++i) { int R, C; stage_rc(tid * 16 + i * 8192, R, C); const int Rb = Epi::PERM ? ((R & ~31) + perm32(R & 31)) : R;
        voffA[i] = (unsigned)(R * K + C) * 2u; voffB[i] = (unsigned)(Rb * K + C) * 2u; }
    const size_t kstep = (size_t)(BK * 2);
    const size_t hstep = (size_t)HALF * K * 2;
    const size_t tstep = 2 * hstep;
    const unsigned ldsw = (unsigned)wid * 1024u;
    const int aoff = lds_byte(wr * 64 + fr, fq * 8), boff = lds_byte(wc * 32 + fr, fq * 8);
#define PG8_SA(b, h) (((b) * 2 + (h)) * HTB)
#define PG8_SB(b, h) ((4 + (b) * 2 + (h)) * HTB)
#define PG8_STAGE(bufoff, gbase, voff) do { if constexpr (!pg8_noload<Epi>::value) { _Pragma("unroll") for (int _i = 0; _i < 2; ++_i) \
        __builtin_amdgcn_global_load_lds((const unsigned*)((const char*)(gbase) + (voff)[_i]), (PG8_LAS unsigned*)(lds + (bufoff) + ldsw + _i * 8192), 16, 0, 0); } } while (0)
#define PG8_LDA(dst, b, h) do { _Pragma("unroll") for (int m = 0; m < 4; ++m) _Pragma("unroll") for (int k = 0; k < 2; ++k) dst[m][k] = *(const PG8_LAS bf16x8*)(lds + PG8_SA(b, h) + aoff + m * 2048 + k * 1024); } while (0)
#define PG8_LDB(dst, b, h) do { _Pragma("unroll") for (int n = 0; n < 2; ++n) _Pragma("unroll") for (int k = 0; k < 2; ++k) dst[n][k] = *(const PG8_LAS bf16x8*)(lds + PG8_SB(b, h) + boff + n * 2048 + k * 1024); } while (0)
#define PG8_MMA(ai, bj, At, Bt) do { __builtin_amdgcn_s_setprio(1); _Pragma("unroll") for (int m = 0; m < 4; ++m) _Pragma("unroll") for (int n = 0; n < 2; ++n) _Pragma("unroll") for (int k = 0; k < 2; ++k) \
        acc[ai][bj][m][n] = __builtin_amdgcn_mfma_f32_16x16x32_bf16(Bt[n][k], At[m][k], acc[ai][bj][m][n], 0, 0, 0); __builtin_amdgcn_s_setprio(0); } while (0)
#define PG8_WAIT_V(n) asm volatile("s_waitcnt vmcnt(" #n ")" ::: "memory")
#define PG8_WAIT_L(n) asm volatile("s_waitcnt lgkmcnt(" #n ")" ::: "memory")
#define PG8_BAR __builtin_amdgcn_s_barrier()
#define PG8_SCHED __builtin_amdgcn_sched_barrier(0)
    Unit cur, nxt; int ui = 0;
    if (!S.next(0, cur)) return;
    f32x4 acc[2][2][4][2];
#pragma unroll
    for (int a = 0; a < 2; ++a)
#pragma unroll
        for (int b = 0; b < 2; ++b)
#pragma unroll
            for (int m = 0; m < 4; ++m)
#pragma unroll
                for (int n = 0; n < 2; ++n) acc[a][b][m][n] = (f32x4){0.f, 0.f, 0.f, 0.f};
    bf16x8 At[4][2], B0[2][2], B1[2][2];
    const char* cA = (const char*)g.A + (size_t)cur.pm * tstep + (size_t)cur.ko * 2; const char* cB = (const char*)g.Bt + (size_t)cur.pn * tstep + (size_t)cur.ko * 2; int nt = cur.nt;
    S.a_ready(cur);
    if constexpr (SP2) {
        PG8_STAGE(PG8_SB(0, 0), cB, voffB); PG8_STAGE(PG8_SB(0, 1), cB + hstep, voffB); PG8_STAGE(PG8_SA(0, 0), cA, voffA); PG8_STAGE(PG8_SA(0, 1), cA + hstep, voffA);
        if (wr == 1) PG8_BAR;
        PG8_WAIT_V(2); PG8_BAR;
        PG8_STAGE(PG8_SB(1, 0), cB + kstep, voffB); PG8_STAGE(PG8_SA(1, 0), cA + kstep, voffA); PG8_STAGE(PG8_SB(1, 1), cB + hstep + kstep, voffB);
        PG8_WAIT_V(6); PG8_BAR;
    } else {
        PG8_STAGE(PG8_SB(0, 0), cB, voffB); PG8_STAGE(PG8_SA(0, 0), cA, voffA); PG8_STAGE(PG8_SB(0, 1), cB + hstep, voffB); PG8_STAGE(PG8_SA(0, 1), cA + hstep, voffA);
        if (wr == 1) PG8_BAR;
        PG8_WAIT_V(4); PG8_BAR;
        PG8_STAGE(PG8_SB(1, 0), cB + kstep, voffB); PG8_STAGE(PG8_SA(1, 0), cA + kstep, voffA); PG8_STAGE(PG8_SB(1, 1), cB + hstep + kstep, voffB);
        PG8_WAIT_V(6); PG8_BAR;
    }
    for (;;) {
        const bool has_next = S.next(ui + 1, nxt);
        const char* nA = has_next ? (const char*)g.A + (size_t)nxt.pm * tstep + (size_t)nxt.ko * 2 : cA; const char* nB = has_next ? (const char*)g.Bt + (size_t)nxt.pn * tstep + (size_t)nxt.ko * 2 : cB;
        for (int t = 0; t < nt; t += 2) {
            const bool last = (t == nt - 2);
            const char* a1 = cA + (size_t)(t + 1) * kstep;
            const char* a2 = last ? nA : cA + (size_t)(t + 2) * kstep; const char* b2 = last ? nB : cB + (size_t)(t + 2) * kstep;
            const char* a3 = a2 + kstep; const char* b3 = b2 + kstep;
            if (last && has_next) S.a_ready(nxt);
            if constexpr (SP2) {
            PG8_LDB(B0, 0, 0); PG8_LDB(B1, 0, 1); PG8_SCHED; PG8_LDA(At, 0, 0); PG8_STAGE(PG8_SA(1, 1), a1 + hstep, voffA);
            PG8_WAIT_V(8); PG8_WAIT_L(0); PG8_BAR; PG8_MMA(0, 0, At, B0); PG8_MMA(0, 1, At, B1); PG8_BAR; PG8_SCHED;
            PG8_LDA(At, 0, 1); PG8_STAGE(PG8_SB(0, 0), b2, voffB); PG8_STAGE(PG8_SB(0, 1), b2 + hstep, voffB); PG8_STAGE(PG8_SA(0, 0), a2, voffA);
            PG8_WAIT_V(8); PG8_WAIT_L(0); PG8_BAR; PG8_MMA(1, 0, At, B0); PG8_MMA(1, 1, At, B1); PG8_BAR; PG8_SCHED;
            PG8_LDB(B0, 1, 0); PG8_LDB(B1, 1, 1); PG8_SCHED; PG8_LDA(At, 1, 0); PG8_STAGE(PG8_SA(0, 1), a2 + hstep, voffA);
            PG8_WAIT_V(8); PG8_WAIT_L(0); PG8_BAR; PG8_MMA(0, 0, At, B0); PG8_MMA(0, 1, At, B1); PG8_BAR; PG8_SCHED;
            PG8_LDA(At, 1, 1); PG8_STAGE(PG8_SB(1, 0), b3, voffB); PG8_STAGE(PG8_SB(1, 1), b3 + hstep, voffB); PG8_STAGE(PG8_SA(1, 0), a3, voffA);
            PG8_WAIT_V(8); PG8_WAIT_L(0); PG8_BAR; PG8_MMA(1, 0, At, B0); PG8_MMA(1, 1, At, B1); PG8_BAR; PG8_SCHED;
            } else {
            PG8_LDB(B0, 0, 0); PG8_SCHED; PG8_LDA(At, 0, 0); PG8_STAGE(PG8_SA(1, 1), a1 + hstep, voffA);
            PG8_WAIT_L(8); PG8_BAR; PG8_WAIT_L(0); PG8_MMA(0, 0, At, B0); PG8_BAR; PG8_SCHED;
            PG8_LDB(B1, 0, 1); PG8_STAGE(PG8_SB(0, 0), b2, voffB);
            PG8_BAR; PG8_WAIT_L(0); PG8_MMA(0, 1, At, B1); PG8_BAR;
            PG8_LDA(At, 0, 1); PG8_STAGE(PG8_SA(0, 0), a2, voffA);
            PG8_BAR; PG8_WAIT_L(0); PG8_MMA(1, 0, At, B0); PG8_BAR; PG8_SCHED;
            PG8_STAGE(PG8_SB(0, 1), b2 + hstep, voffB);
            PG8_WAIT_V(6); PG8_BAR; PG8_MMA(1, 1, At, B1); PG8_BAR;
            PG8_LDB(B0, 1, 0); PG8_SCHED; PG8_LDA(At, 1, 0); PG8_STAGE(PG8_SA(0, 1), a2 + hstep, voffA);
            PG8_WAIT_L(8); PG8_BAR; PG8_WAIT_L(0); PG8_MMA(0, 0, At, B0); PG8_BAR; PG8_SCHED;
            PG8_LDB(B1, 1, 1); PG8_STAGE(PG8_SB(1, 0), b3, voffB);
            PG8_BAR; PG8_WAIT_L(0); PG8_MMA(0, 1, At, B1); PG8_BAR;
            PG8_LDA(At, 1, 1); PG8_STAGE(PG8_SA(1, 0), a3, voffA);
            PG8_BAR; PG8_WAIT_L(0); PG8_MMA(1, 0, At, B0); PG8_BAR; PG8_SCHED;
            PG8_STAGE(PG8_SB(1, 1), b3 + hstep, voffB);
            PG8_WAIT_V(6); PG8_BAR; PG8_MMA(1, 1, At, B1); PG8_BAR;
            }
        }
        if constexpr (ALIGN_EPI) { if (wr == 0) PG8_BAR; }
        if constexpr (!Epi::AFTER_DRAIN) { E(acc, cur, wr, wc, fr, fq); S.done(cur); }
        if (!has_next) break;
#pragma unroll
        for (int a = 0; a < 2; ++a)
#pragma unroll
            for (int b = 0; b < 2; ++b)
#pragma unroll
                for (int m = 0; m < 4; ++m)
#pragma unroll
                    for (int n = 0; n < 2; ++n) acc[a][b][m][n] = (f32x4){0.f, 0.f, 0.f, 0.f};
        cur = nxt; cA = nA; cB = nB; ++ui; nt = cur.nt;
        if constexpr (ALIGN_EPI) { if (wr == 1) PG8_BAR; }
    }
    PG8_WAIT_V(0);
    if constexpr (!ALIGN_EPI) { if (wr == 0) PG8_BAR; }
    PG8_BAR;
    if constexpr (Epi::AFTER_DRAIN) { E.fused(acc, cur, wr, wc, fr, fq, lds, wid, lane); S.done(cur); }
#undef PG8_SA
#undef PG8_SB
#undef PG8_STAGE
#undef PG8_LDA
#undef PG8_LDB
#undef PG8_MMA
#undef PG8_WAIT_V
#undef PG8_WAIT_L
#undef PG8_BAR
#undef PG8_SCHED
}
}

#define LAS __attribute__((address_space(3)))
#define XB_TMO      128
#define XB_XCNT(j)  (256  + 64 * (j))
#define XB_XSUB(j)  (1280 + 64 * (j))
#define XB_XGEN(j)  (2304 + 64 * (j))
#define XB_TOP      3328
#define XB_TOPGEN   3392
#define XCD_BAR_WORDS 3456
#define XB_SPIN_CAP (1u << 18)

__device__ __forceinline__ unsigned xb_ld(unsigned* p)              { return __hip_atomic_load(p, __ATOMIC_RELAXED, __HIP_MEMORY_SCOPE_AGENT); }
__device__ __forceinline__ unsigned xb_add(unsigned* p, unsigned v) { return __hip_atomic_fetch_add(p, v, __ATOMIC_RELAXED, __HIP_MEMORY_SCOPE_AGENT); }
__device__ __forceinline__ unsigned xb_xcc_id() { return (unsigned)__builtin_amdgcn_s_getreg((3 << 11) | 20) & 0xFu; }
#define XB_SPIN(cond, bar) do { unsigned _sp = 0; while (cond) { __builtin_amdgcn_s_sleep(1); \
    if ((++_sp & 255u) == 0u) { if (xb_ld(&(bar)[XB_TMO])) break; if (_sp > XB_SPIN_CAP) { atomicAdd(&(bar)[XB_TMO], 1u); break; } } } } while (0)

struct XcdBarrier {
    unsigned* bar; unsigned x;
    volatile LAS unsigned* st;
};

__device__ __forceinline__ XcdBarrier xcd_barrier_post(unsigned* bar, volatile LAS unsigned* st) {
    XcdBarrier b; b.bar = bar; b.x = xb_xcc_id(); b.st = st;
    if (threadIdx.x == 0) (void)xb_add(&bar[XB_XCNT(b.x)], 1u);
    return b;
}
__device__ __forceinline__ void xcd_barrier_complete(unsigned* bar, unsigned x, unsigned& nloc, unsigned& nx) {
    const unsigned G = gridDim.x * gridDim.y * gridDim.z;
    unsigned sum, cnt, mine, sp = 0u;
    for (;;) {
        sum = 0u; cnt = 0u; mine = 0u;
#pragma unroll
        for (unsigned j = 0; j < 16; ++j) { const unsigned c = xb_ld(&bar[XB_XCNT(j)]); sum += c; cnt += (c > 0u) ? 1u : 0u; mine = (j == x) ? c : mine; }
        if (sum == G) break;
        __builtin_amdgcn_s_sleep(1);
        if ((++sp & 255u) == 0u) { if (xb_ld(&bar[XB_TMO])) break; if (sp > XB_SPIN_CAP) { atomicAdd(&bar[XB_TMO], 1u); break; } }
    }
    nloc = mine > 0u ? mine : 1u; nx = cnt > 0u ? cnt : 1u;
}

__device__ __forceinline__ void xcd_barrier(const XcdBarrier& b) {
    asm volatile("s_waitcnt vmcnt(0)" ::: "memory");
    __syncthreads();
    if (threadIdx.x == 0) {
        unsigned* bar = b.bar;
        __builtin_amdgcn_s_waitcnt(0);
        unsigned nloc = b.st[0], nx = b.st[1];
        if (nloc == 0u) { xcd_barrier_complete(bar, b.x, nloc, nx); b.st[0] = nloc; b.st[1] = nx; }
        const unsigned old = xb_add(&bar[XB_XSUB(b.x)], 1u);
        const unsigned gen = old / nloc;
        if (old + 1u == (gen + 1u) * nloc) {
            __builtin_amdgcn_fence(__ATOMIC_RELEASE, "agent");
            asm volatile("s_waitcnt vmcnt(0)" ::: "memory");
            const unsigned og = xb_add(&bar[XB_TOP], 1u);
            const unsigned tg = og / nx;
            if (og + 1u == (tg + 1u) * nx) xb_add(&bar[XB_TOPGEN], 1u);
            else XB_SPIN(xb_ld(&bar[XB_TOPGEN]) == tg, bar);
            __builtin_amdgcn_fence(__ATOMIC_ACQUIRE, "agent");
            xb_add(&bar[XB_XGEN(b.x)], 1u);
            asm volatile("s_waitcnt vmcnt(0)" ::: "memory");
        } else {
            XB_SPIN(xb_ld(&bar[XB_XGEN(b.x)]) == gen, bar);
            __builtin_amdgcn_fence(__ATOMIC_ACQUIRE, "agent");
            asm volatile("s_waitcnt vmcnt(0)" ::: "memory");
        }
    }
    __syncthreads();
}

constexpr int NWAVES = 8, NTHREADS = 512;
constexpr int D = 2048, SEQ = 16384, NSMP = 512, M = SEQ + NSMP;
constexpr int AW = 4096;
constexpr int B_DI = 4096, B_CD = 6144, B_INP = 10496;
constexpr int HP = D;
constexpr float EPS = 1e-6f;
#ifndef MK_ONE_LAUNCH
#define MK_ONE_LAUNCH 1
#endif
constexpr int NPHASES = 20;
#ifndef STAG_TICKS
#define STAG_TICKS 4500
#endif

constexpr size_t O_YP = 0, O_YS = 33554432, O_GV = 34603008, O_SSMP = 38797312, O_CONVP = 39321600, O_SSMS = 39340032, O_CONVS = 56117248,
                 O_KP = 56707072, O_VP = 90261504, O_KS = 123815936, O_VS = 124864512, O_END = 125913088;

constexpr size_t MiB = 1u << 20;
constexpr size_t WS_CTL = 0, CTL_ZERO_BYTES = 1 * MiB;
constexpr size_t WS_WA_IN = 1 * MiB, WA_IN_BYTES = 50 * MiB;
constexpr size_t WS_WA_OUT = WS_WA_IN + 2 * WA_IN_BYTES;
constexpr size_t WS_WB_IN = WS_WA_OUT + 32 * MiB;
constexpr size_t WS_WB_OUT = WS_WB_IN + 43 * MiB;
constexpr size_t WS_WC_IN = WS_WB_OUT + 16 * MiB;
constexpr size_t WS_WC_OUT = WS_WC_IN + 34 * MiB;
constexpr size_t WS_X = WS_WC_OUT + 8 * MiB;
constexpr size_t WS_RSTD = WS_CTL + 64 * 1024, WS_SSQ = WS_CTL + 256 * 1024;
constexpr size_t WS_H = WS_X + 132 * MiB;
constexpr size_t WS_S = WS_H + 70 * MiB;
constexpr size_t WS_U = WS_S, WS_GV = WS_U + 132 * MiB, WS_Z = WS_GV + 132 * MiB, WS_STATS = WS_Z + 132 * MiB;
constexpr size_t WS_ZS = WS_X;
constexpr size_t WS_XC = WS_S;
constexpr size_t WS_XBC = WS_XC + 198 * MiB;
constexpr size_t WS_ST = WS_XBC + 198 * MiB;
constexpr size_t WS_DT = WS_ST + 256 * MiB;
constexpr size_t WS_CD = WS_DT + 5 * MiB;
constexpr size_t WS_B_END = WS_CD + 1 * MiB;
constexpr size_t WS_Q = WS_S, WS_K = WS_Q + 66 * MiB, WS_V = WS_K + 66 * MiB, WS_CZ = WS_V + 66 * MiB;
constexpr size_t WS_DUMMY = WS_B_END;
#ifndef PROBE_DUP
#define PROBE_DUP 0
#endif
#define PROBE(k, ...) do { if (PROBE_DUP == (k)) { __VA_ARGS__; __syncthreads(); } } while (0)
constexpr size_t WS_PART = WS_S + 132 * MiB;
constexpr size_t WS_END = WS_B_END + (PROBE_DUP ? 133 * MiB : 0);
static_assert(WS_STATS + 9 * MiB <= WS_END && WS_CZ + 66 * MiB <= WS_END, "d_ws map");
constexpr int CW_BAR = 4096;

constexpr int RING_BYTES = 131072;
constexpr int LDSCTL_OFF = RING_BYTES, MISC_OFF = LDSCTL_OFF + 320;
constexpr int LDS_BYTES = 147456;
constexpr int EPI_LDS_OFF = RING_BYTES + 2048;

#define GAS __attribute__((address_space(1)))
typedef unsigned short bf16;
typedef unsigned v4u __attribute__((ext_vector_type(4)));
typedef unsigned v2u __attribute__((ext_vector_type(2)));
typedef float f32x4 __attribute__((ext_vector_type(4)));
typedef float f32x2 __attribute__((ext_vector_type(2)));
typedef short bf16x8 __attribute__((ext_vector_type(8)));
typedef short bf16x4 __attribute__((ext_vector_type(4)));
typedef GAS unsigned gu32;
#define RLX_AGENT __ATOMIC_RELAXED, __HIP_MEMORY_SCOPE_AGENT
#define LDS_WAIT() asm volatile("s_waitcnt lgkmcnt(0)" ::: "memory")
__device__ __forceinline__ unsigned f2bf(float f) { unsigned u = __builtin_bit_cast(unsigned, f); return (u + 0x7fffu + ((u >> 16) & 1u)) >> 16; }
typedef float cvt_f2 __attribute__((ext_vector_type(2))); typedef __bf16 cvt_b2 __attribute__((ext_vector_type(2)));
__device__ __forceinline__ unsigned pk2(float lo, float hi) { const cvt_f2 v = {lo, hi}; const cvt_b2 r = __builtin_convertvector(v, cvt_b2); return __builtin_bit_cast(unsigned, r); }
__device__ __forceinline__ float bflo(unsigned w) { return __builtin_bit_cast(float, w << 16); }
__device__ __forceinline__ float bfhi(unsigned w) { return __builtin_bit_cast(float, w & 0xffff0000u); }
__device__ __forceinline__ float wave_sum(float v) {
#pragma unroll
    for (int o = 1; o < 64; o <<= 1) v += __shfl_xor(v, o);
    return v;
}
__device__ __forceinline__ float silu_f(float v) { return v * __builtin_amdgcn_rcpf(1.0f + __builtin_amdgcn_exp2f(-1.44269504f * v)); }
__device__ __forceinline__ bf16x8 tr_read2(unsigned a0, unsigned a1) {
    bf16x4 lo, hi;
    asm volatile("ds_read_b64_tr_b16 %0, %2\n\tds_read_b64_tr_b16 %1, %3\n\ts_waitcnt lgkmcnt(0)" : "=&v"(lo), "=&v"(hi) : "v"(a0), "v"(a1) : "memory");
    return __builtin_shufflevector(lo, hi, 0, 1, 2, 3, 4, 5, 6, 7);
}
__device__ __forceinline__ void tr_read_x4(const unsigned (&a)[4], unsigned d, bf16x8 (&f)[4]) {
    bf16x4 l0, h0, l1, h1, l2, h2, l3, h3;
    asm volatile("ds_read_b64_tr_b16 %0, %8\n\tds_read_b64_tr_b16 %1, %9\n\tds_read_b64_tr_b16 %2, %10\n\tds_read_b64_tr_b16 %3, %11\n\t"
                 "ds_read_b64_tr_b16 %4, %12\n\tds_read_b64_tr_b16 %5, %13\n\tds_read_b64_tr_b16 %6, %14\n\tds_read_b64_tr_b16 %7, %15\n\ts_waitcnt lgkmcnt(0)"
                 : "=&v"(l0), "=&v"(h0), "=&v"(l1), "=&v"(h1), "=&v"(l2), "=&v"(h2), "=&v"(l3), "=&v"(h3)
                 : "v"(a[0]), "v"(a[0] + d), "v"(a[1]), "v"(a[1] + d), "v"(a[2]), "v"(a[2] + d), "v"(a[3]), "v"(a[3] + d) : "memory");
    f[0] = __builtin_shufflevector(l0, h0, 0, 1, 2, 3, 4, 5, 6, 7); f[1] = __builtin_shufflevector(l1, h1, 0, 1, 2, 3, 4, 5, 6, 7);
    f[2] = __builtin_shufflevector(l2, h2, 0, 1, 2, 3, 4, 5, 6, 7); f[3] = __builtin_shufflevector(l3, h3, 0, 1, 2, 3, 4, 5, 6, 7);
}
#define MFMA16(a, b, c) __builtin_amdgcn_mfma_f32_16x16x32_bf16((a), (b), (c), 0, 0, 0)

struct Frame {
    LAS unsigned char* lds; unsigned lds0;
    int tid, lane, wave, G;
    const float *x_prompt, *x_sample, *state_ssm, *state_conv, *cache_k, *cache_v, *norm_w, *final_norm_w;
    const float *a_w_in, *a_ln_g, *a_ln_b, *a_w_s, *a_b_s, *a_w_out;
    const float *b_w_in, *b_conv_w, *b_conv_b, *b_dt_bias, *b_a_log, *b_d, *b_norm_w, *b_w_out, *c_w_in, *c_w_out;
    float* out; unsigned char* ws;
};
#define WSP(T, off) ((T*)(F.ws + (off)))

struct TRes { const float* W; bf16* WT; const float* ks; int N, pitch, item; };
__device__ __forceinline__ void t_load(const TRes& r, int lane, f32x4 (&v)[8]) {
    const int nblk = r.N / 32, kb = r.item / nblk, nb = r.item % nblk, k0 = 64 * kb, n0 = 32 * nb, kr = lane >> 3, c4 = (lane & 7) * 4;
#pragma unroll
    for (int i = 0; i < 8; ++i) v[i] = *(const GAS f32x4*)(r.W + (size_t)(k0 + 8 * i + kr) * r.N + n0 + c4);
}
__device__ __forceinline__ void t_finish(const TRes& r, int lane, LAS float* scr, const f32x4 (&v)[8]) {
    const int nblk = r.N / 32, kb = r.item / nblk, nb = r.item % nblk, k0 = 64 * kb, n0 = 32 * nb, kr = lane >> 3, c4 = (lane & 7) * 4;
#pragma unroll
    for (int i = 0; i < 8; ++i) { const int kk = 8 * i + kr; const float sc = r.ks ? r.ks[k0 + kk] : 1.0f; LAS float* d = scr + kk * 33 + c4;
        d[0] = v[i].x * sc; d[1] = v[i].y * sc; d[2] = v[i].z * sc; d[3] = v[i].w * sc; }
    LDS_WAIT(); asm volatile("" ::: "memory");
    const int c = lane & 7;
#pragma unroll
    for (int j = 0; j < 4; ++j) { const int n = (lane >> 3) + 8 * j; const LAS float* s = scr + (8 * c) * 33 + n;
        v4u o; o.x = pk2(s[0 * 33], s[1 * 33]); o.y = pk2(s[2 * 33], s[3 * 33]); o.z = pk2(s[4 * 33], s[5 * 33]); o.w = pk2(s[6 * 33], s[7 * 33]);
        *(GAS v4u*)(r.WT + (size_t)(n0 + n) * r.pitch + k0 + 8 * c) = o; }
    LDS_WAIT(); asm volatile("" ::: "memory");
}
__device__ __forceinline__ void row_f32_to_xb(const float* xrow, bf16* orow, float* rstd_out, int lane) {
    const GAS f32x4* xr = (const GAS f32x4*)xrow + lane;
    f32x4 v[8]; float s = 0.f;
#pragma unroll
    for (int j = 0; j < 8; ++j) { v[j] = xr[64 * j]; s += (v[j].x * v[j].x + v[j].y * v[j].y) + (v[j].z * v[j].z + v[j].w * v[j].w); }
    s = wave_sum(s);
    GAS v2u* o8 = (GAS v2u*)orow + lane;
#pragma unroll
    for (int j = 0; j < 8; ++j) { v2u o; o.x = pk2(v[j].x, v[j].y); o.y = pk2(v[j].z, v[j].w); o8[64 * j] = o; }
    if (lane == 0) *rstd_out = 1.0f / sqrtf(s * (1.f / D) + EPS);
}
__device__ __forceinline__ float row_xb_plus_parts(const bf16* xbrow, const float* part, int nsplit, f32x4 (&v)[8], int lane) {
    const GAS v2u* xr = (const GAS v2u*)xbrow + lane;
#pragma unroll
    for (int j = 0; j < 8; ++j) { const v2u r = xr[64 * j]; v[j] = (f32x4){bflo(r.x), bfhi(r.x), bflo(r.y), bfhi(r.y)}; }
    for (int sp = 0; sp < nsplit; ++sp) { const GAS f32x4* pr = (const GAS f32x4*)(part + (size_t)sp * NSMP * D) + lane;
#pragma unroll
        for (int j = 0; j < 8; ++j) v[j] = v[j] + pr[64 * j]; }
    float s = 0.f;
#pragma unroll
    for (int j = 0; j < 8; ++j) s += (v[j].x * v[j].x + v[j].y * v[j].y) + (v[j].z * v[j].z + v[j].w * v[j].w);
    return wave_sum(s);
}

template <int JOB> __device__ __forceinline__ TRes convert_item_of(const Frame& F, int it) {
    constexpr int I_AIN = (D / 64) * (12288 / 32), I_BIN = (D / 64) * (10304 / 32), I_CIN = (D / 64) * (8192 / 32);
    if constexpr (JOB == 0) return TRes{F.a_w_in, WSP(bf16, WS_WA_IN), F.norm_w, 12288, HP, it};
    else if constexpr (JOB == 4) return TRes{F.a_w_out, WSP(bf16, WS_WA_OUT), nullptr, D, AW, it};
    else if constexpr (JOB == 3) { if (it < I_AIN) return TRes{F.a_w_in + (size_t)D * 12288, WSP(bf16, WS_WA_IN + WA_IN_BYTES), F.norm_w + 3 * D, 12288, HP, it};
                                   return TRes{F.a_w_out + (size_t)AW * D, WSP(bf16, WS_WA_OUT + 16 * MiB), nullptr, D, AW, it - I_AIN}; }
    else if constexpr (JOB == 1) { if (it < I_BIN) return TRes{F.b_w_in, WSP(bf16, WS_WB_IN), F.norm_w + 1 * D, 10304, HP, it};
                                   return TRes{F.b_w_out, WSP(bf16, WS_WB_OUT), nullptr, D, B_DI, it - I_BIN}; }
    else { if (it < I_CIN) return TRes{F.c_w_in, WSP(bf16, WS_WC_IN), F.norm_w + 2 * D, 8192, HP, it};
           return TRes{F.c_w_out, WSP(bf16, WS_WC_OUT), nullptr, D, D, it - I_CIN}; }
}
template <int JOB> __device__ __forceinline__ void convert_job(Frame& F, int gw, int NGW) {
    LAS float* scr = (LAS float*)(F.lds + F.wave * 16384);
    constexpr int I_AIN = (D / 64) * (12288 / 32), I_AOUT = (AW / 64) * (D / 32), I_BIN = (D / 64) * (10304 / 32), I_BOUT = (B_DI / 64) * (D / 32), I_CIN = (D / 64) * (8192 / 32), I_COUT = (D / 64) * (D / 32);
    constexpr int NI = JOB == 0 ? I_AIN : JOB == 4 ? I_AOUT : JOB == 3 ? I_AIN + I_AOUT : JOB == 1 ? I_BIN + I_BOUT : I_CIN + I_COUT;
    for (int it = gw; it < NI; it += 2 * NGW) {
        const TRes ra = convert_item_of<JOB>(F, it); f32x4 va[8], vb[8]; t_load(ra, F.lane, va);
        const bool hb = it + NGW < NI; TRes rb = ra; if (hb) { rb = convert_item_of<JOB>(F, it + NGW); t_load(rb, F.lane, vb); }
        t_finish(ra, F.lane, scr, va);
        if (hb) t_finish(rb, F.lane, scr, vb);
    }
    if constexpr (JOB == 1) { GAS v4u* z = (GAS v4u*)(F.ws + WS_WB_IN + (size_t)10304 * HP * 2); const int n16 = 192 * HP * 2 / 16;
        for (int i = gw * 64 + F.lane; i < n16; i += NGW * 64) z[i] = (v4u){0u, 0u, 0u, 0u}; }
}
template <int JOB> __device__ __forceinline__ void convert_in_tail(Frame& F, int nunits) {
    const int nb = nunits % F.G, c = (int)blockIdx.x;
    if (nb == 0) convert_job<JOB>(F, c * NWAVES + F.wave, F.G * NWAVES);
    else if (c >= nb) convert_job<JOB>(F, (c - nb) * NWAVES + F.wave, (F.G - nb) * NWAVES);
}
__device__ __forceinline__ void p0_prologue(Frame& F) {
    const int gw = blockIdx.x * NWAVES + F.wave, NGW = F.G * NWAVES;
    convert_job<0>(F, gw, NGW);
    for (int m = gw; m < M; m += NGW) {
        const float* src = m < SEQ ? F.x_prompt + (size_t)m * D : F.x_sample + (size_t)(m - SEQ) * D;
        row_f32_to_xb(src, WSP(bf16, WS_H) + (size_t)m * HP, WSP(float, WS_RSTD) + m, F.lane);
    }
}
__device__ __forceinline__ void rstd_phase(Frame& F, int nsplit) {
    float* rstd = WSP(float, WS_RSTD); const float* ssq = WSP(float, WS_SSQ);
    for (int m = blockIdx.x * NTHREADS + F.tid; m < SEQ; m += F.G * NTHREADS) { const f32x4 a = *(const f32x4*)(ssq + (size_t)m * 8), b = *(const f32x4*)(ssq + (size_t)m * 8 + 4);
        rstd[m] = 1.0f / sqrtf((((a.x + a.y) + (a.z + a.w)) + ((b.x + b.y) + (b.z + b.w))) * (1.f / D) + EPS); }
    for (int r = (int)blockIdx.x + F.wave * F.G; r < NSMP; r += F.G * NWAVES) { const int m = SEQ + r; bf16* xb = WSP(bf16, WS_H) + (size_t)m * HP; f32x4 v[8];
        const float s = row_xb_plus_parts(xb, WSP(float, WS_PART) + (size_t)r * D, nsplit, v, F.lane);
        GAS v2u* o8 = (GAS v2u*)xb + F.lane;
#pragma unroll
        for (int j = 0; j < 8; ++j) { v2u o; o.x = pk2(v[j].x, v[j].y); o.y = pk2(v[j].z, v[j].w); o8[64 * j] = o; }
        if (F.lane == 0) rstd[m] = 1.0f / sqrtf(s * (1.f / D) + EPS); }
}
__device__ __forceinline__ void final_phase(Frame& F, int nsplit) {
    const int gw = blockIdx.x * NWAVES + F.wave, NGW = F.G * NWAVES; const float* ssq = WSP(float, WS_SSQ);
    for (int m = gw; m < M; m += NGW) { const bool smp = m >= SEQ; f32x4 v[8];
        float s = row_xb_plus_parts(WSP(bf16, WS_H) + (size_t)m * HP, WSP(float, WS_PART) + (size_t)(smp ? m - SEQ : 0) * D, smp ? nsplit : 0, v, F.lane);
        if (!smp) { const f32x4 a = *(const f32x4*)(ssq + (size_t)m * 8), b = *(const f32x4*)(ssq + (size_t)m * 8 + 4); s = ((a.x + a.y) + (a.z + a.w)) + ((b.x + b.y) + (b.z + b.w)); }
        const float rstd = 1.0f / sqrtf(s * (1.f / D) + EPS);
        const GAS f32x4* wr = (const GAS f32x4*)F.final_norm_w + F.lane; GAS f32x4* o = (GAS f32x4*)(F.out + O_YP + (size_t)m * D) + F.lane;
#pragma unroll
        for (int j = 0; j < 8; ++j) o[64 * j] = v[j] * rstd * wr[64 * j]; }
}

__device__ __forceinline__ void gmlp_mix_phase(Frame& F, int j, bf16* Ydst) {
    constexpr int WA_OFF = 0, WA_ST = 272, VT_OFF = 34816, VT_ST = 528, MS_OFF = VT_OFF + 128 * VT_ST;
    LAS unsigned char* L = F.lds;
    LAS float* meanv = (LAS float*)(L + MS_OFF); LAS float* rstdv = meanv + 128; LAS float* bsv = meanv + 256;
    const float* w_s = F.a_w_s + (size_t)j * 16 * 128 * 128; const float* b_s = F.a_b_s + (size_t)j * 16 * 128;
    const float* ln_g = F.a_ln_g + (size_t)j * AW; const float* ln_b = F.a_ln_b + (size_t)j * AW;
    const bf16* U = WSP(bf16, WS_U); const bf16* GV = WSP(bf16, WS_GV); const bf16* Z = WSP(bf16, WS_Z); const float* stats = WSP(float, WS_STATS);
    float* out_gv = F.out + O_GV + (size_t)j * NSMP * AW;
    const int tid0 = F.tid, wave = F.wave, wr = wave >> 2, wc = wave & 3;
    constexpr int NU = 132 * 16;
    int wtag = -1;
    v4u vraw[8]; f32x4 sp0, sp1;
    int u = blockIdx.x;
    if (u < NU) { const int tid = tid0; const int c = u >> 4, g = u & 15, tok0 = c * 128;
#pragma unroll
        for (int i = 0; i < 8; ++i) { const int idx = tid + i * NTHREADS, s = idx >> 5, c8 = (idx & 31) * 8; vraw[i] = *(const v4u*)(GV + (size_t)(tok0 + s) * AW + g * 256 + c8); }
        const f32x4* sp = (const f32x4*)(stats + ((size_t)(tok0 + (tid >> 2)) * 16 + (tid & 3) * 4) * 2); sp0 = sp[0]; sp1 = sp[1]; }
    for (; u < NU; u += F.G) {
        int tid = tid0; asm volatile("" : "+v"(tid));
        const int lane = tid & 63, l15 = lane & 15, g4 = lane >> 4, q = (lane & 15) >> 2, p = lane & 3;
        const int c = u >> 4, g = u & 15; const bool smp = c >= 128; const int tok0 = c * 128;
        { float s = (sp0.x + sp0.z) + (sp1.x + sp1.z), qq = (sp0.y + sp0.w) + (sp1.y + sp1.w);
          s += __shfl_xor(s, 1); s += __shfl_xor(s, 2); qq += __shfl_xor(qq, 1); qq += __shfl_xor(qq, 2);
          if ((tid & 3) == 0) { const float mean = s * (1.f / AW); const float var = fmaxf(qq * (1.f / AW) - mean * mean, 0.f); meanv[tid >> 2] = mean; rstdv[tid >> 2] = 1.0f / sqrtf(var + EPS); } }
        __syncthreads();
        const int tag = g * 2 + (smp ? 1 : 0);
        if (tag != wtag) { wtag = tag;
#pragma unroll
            for (int i = 0; i < 8; ++i) { const int idx = tid + i * NTHREADS, t = idx >> 5, s4 = (idx & 31) * 4; f32x4 v = (f32x4){0.f, 0.f, 0.f, 0.f};
                if (!smp) { if ((s4 >> 6) <= (t >> 6)) v = *(const f32x4*)(w_s + ((size_t)g * 128 + t) * 128 + s4); }
                else { if ((s4 >> 4) == (t >> 4)) v = *(const f32x4*)(w_s + ((size_t)g * 128 + (t & 15)) * 128 + (s4 & 15)); }
                v2u o; o.x = pk2(v.x, v.y); o.y = pk2(v.z, v.w); *(LAS v2u*)(L + WA_OFF + t * WA_ST + s4 * 2) = o; }
            if (tid < 128) bsv[tid] = b_s[g * 128 + (smp ? (tid & 15) : tid)]; }
#pragma unroll
        for (int i = 0; i < 8; ++i) { const int idx = tid + i * NTHREADS, s = idx >> 5, c8 = (idx & 31) * 8; const int row = tok0 + s, ch = g * 256 + c8;
            const v4u raw = vraw[i];
            const f32x4 g0 = *(const f32x4*)(ln_g + ch), g1 = *(const f32x4*)(ln_g + ch + 4), b0 = *(const f32x4*)(ln_b + ch), b1 = *(const f32x4*)(ln_b + ch + 4);
            const float mean = meanv[s], rstd = rstdv[s];
            f32x4 v0 = (f32x4){bflo(raw.x), bfhi(raw.x), bflo(raw.y), bfhi(raw.y)}, v1 = (f32x4){bflo(raw.z), bfhi(raw.z), bflo(raw.w), bfhi(raw.w)};
            v0 = (v0 - mean) * rstd * g0 + b0; v1 = (v1 - mean) * rstd * g1 + b1;
            if (smp) { float* o = out_gv + (size_t)(row - SEQ) * AW + ch; *(f32x4*)o = v0; *(f32x4*)(o + 4) = v1; }
            v4u pk; pk.x = pk2(v0.x, v0.y); pk.y = pk2(v0.z, v0.w); pk.z = pk2(v1.x, v1.y); pk.w = pk2(v1.z, v1.w);
            *(LAS v4u*)(L + VT_OFF + s * VT_ST + c8 * 2) = pk; }
        v2u uu[4][4], zz[4][4];
#pragma unroll
        for (int nt = 0; nt < 4; ++nt) { const size_t rbase = (size_t)(tok0 + wr * 64 + 16 * nt + l15) * AW + g * 256 + wc * 64 + 4 * g4;
#pragma unroll
            for (int mt = 0; mt < 4; ++mt) { uu[nt][mt] = *(const v2u*)(U + rbase + 16 * mt); zz[nt][mt] = *(const v2u*)(Z + rbase + 16 * mt); } }
        __syncthreads();
        f32x4 acc[4][4];
#pragma unroll
        for (int a = 0; a < 4; ++a)
#pragma unroll
            for (int b = 0; b < 4; ++b) acc[a][b] = (f32x4){0.f, 0.f, 0.f, 0.f};
        const int ks_end = (!smp && wr == 0) ? 2 : 4;
        for (int ks = 0; ks < ks_end; ++ks) {
            bf16x8 af[4], bfr[4]; unsigned aa[4];
#pragma unroll
            for (int mt = 0; mt < 4; ++mt) aa[mt] = F.lds0 + VT_OFF + (32 * ks + 8 * g4 + q) * VT_ST + (wc * 64 + 16 * mt + 4 * p) * 2;
#pragma unroll
            for (int nt = 0; nt < 4; ++nt) bfr[nt] = *(const LAS bf16x8*)(L + WA_OFF + (wr * 64 + 16 * nt + l15) * WA_ST + (32 * ks + 8 * g4) * 2);
            tr_read_x4(aa, 4 * VT_ST, af);
#pragma unroll
            for (int mt = 0; mt < 4; ++mt)
#pragma unroll
                for (int nt = 0; nt < 4; ++nt) acc[mt][nt] = MFMA16(af[mt], bfr[nt], acc[mt][nt]);
        }
        { const int un = u + F.G; if (un < NU) { const int cn = un >> 4, gn = un & 15, tokn = cn * 128;
#pragma unroll
            for (int i = 0; i < 8; ++i) { const int idx = tid + i * NTHREADS, s = idx >> 5, c8 = (idx & 31) * 8; vraw[i] = *(const v4u*)(GV + (size_t)(tokn + s) * AW + gn * 256 + c8); }
            const f32x4* sp = (const f32x4*)(stats + ((size_t)(tokn + (tid >> 2)) * 16 + (tid & 3) * 4) * 2); sp0 = sp[0]; sp1 = sp[1]; } }
#pragma unroll
        for (int nt = 0; nt < 4; ++nt) { const int tl = wr * 64 + 16 * nt + l15; const float bias = bsv[tl]; const size_t rbase = (size_t)(tok0 + tl) * AW + g * 256 + wc * 64 + 4 * g4;
#pragma unroll
            for (int mt = 0; mt < 4; ++mt) { const v2u ur = uu[nt][mt], zr = zz[nt][mt];
                const pg8::f32x2 ga = pg8::gelu_pk((pg8::f32x2){bflo(ur.x), bfhi(ur.x)}), gb = pg8::gelu_pk((pg8::f32x2){bflo(ur.y), bfhi(ur.y)});
                const f32x4 a = acc[mt][nt]; v2u o;
                o.x = pk2(ga.x * (a.x + bias) * silu_f(bflo(zr.x)), ga.y * (a.y + bias) * silu_f(bfhi(zr.x)));
                o.y = pk2(gb.x * (a.z + bias) * silu_f(bflo(zr.y)), gb.y * (a.w + bias) * silu_f(bfhi(zr.y)));
                *(v2u*)(Ydst + rbase + 16 * mt) = o; } }
    }
    __syncthreads();
}

template <bool SCALE, bool TOLDS, int NT = 8>
__device__ __forceinline__ void conv_item(const Frame& F, const bf16* XBC, bf16* XC, int ch, int row0, int hist_kind, const float* hist, LAS unsigned char* ldst, int lstride, const LAS float* wgt) {
    float w[4][8], bias[8], h[3][8];
#pragma unroll
    for (int k = 0; k < 4; ++k) { const f32x4 a = *(const f32x4*)(F.b_conv_w + k * B_CD + ch), b = *(const f32x4*)(F.b_conv_w + k * B_CD + ch + 4);
        w[k][0] = a.x; w[k][1] = a.y; w[k][2] = a.z; w[k][3] = a.w; w[k][4] = b.x; w[k][5] = b.y; w[k][6] = b.z; w[k][7] = b.w; }
    { const f32x4 a = *(const f32x4*)(F.b_conv_b + ch), b = *(const f32x4*)(F.b_conv_b + ch + 4);
      bias[0] = a.x; bias[1] = a.y; bias[2] = a.z; bias[3] = a.w; bias[4] = b.x; bias[5] = b.y; bias[6] = b.z; bias[7] = b.w; }
    v4u rr[NT];
#pragma unroll
    for (int j = 0; j < NT; ++j) rr[j] = *(const v4u*)(XBC + (size_t)(row0 + j) * B_CD + ch);
#pragma unroll
    for (int k = 0; k < 3; ++k) {
        if (hist_kind == 0) {
#pragma unroll
            for (int e = 0; e < 8; ++e) h[k][e] = 0.f;
        } else if (hist_kind == 2) { const f32x4 a = *(const f32x4*)(hist + (size_t)k * B_CD + ch), b = *(const f32x4*)(hist + (size_t)k * B_CD + ch + 4);
            h[k][0] = a.x; h[k][1] = a.y; h[k][2] = a.z; h[k][3] = a.w; h[k][4] = b.x; h[k][5] = b.y; h[k][6] = b.z; h[k][7] = b.w;
        } else { const v4u r = *(const v4u*)(XBC + (size_t)(row0 - 3 + k) * B_CD + ch);
            h[k][0] = bflo(r.x); h[k][1] = bfhi(r.x); h[k][2] = bflo(r.y); h[k][3] = bfhi(r.y); h[k][4] = bflo(r.z); h[k][5] = bfhi(r.z); h[k][6] = bflo(r.w); h[k][7] = bfhi(r.w); }
    }
#pragma unroll
    for (int j = 0; j < NT; ++j) { const v4u r = rr[j];
        const float cur[8] = {bflo(r.x), bfhi(r.x), bflo(r.y), bfhi(r.y), bflo(r.z), bfhi(r.z), bflo(r.w), bfhi(r.w)}; float o[8];
#pragma unroll
        for (int e = 0; e < 8; ++e) { const float a = bias[e] + w[0][e] * h[0][e] + w[1][e] * h[1][e] + w[2][e] * h[2][e] + w[3][e] * cur[e]; o[e] = silu_f(a); h[0][e] = h[1][e]; h[1][e] = h[2][e]; h[2][e] = cur[e]; }
        v4u pk; pk.x = pk2(o[0], o[1]); pk.y = pk2(o[2], o[3]); pk.z = pk2(o[4], o[5]); pk.w = pk2(o[6], o[7]);
        *(v4u*)(XC + (size_t)(row0 + j) * B_CD + ch) = pk;
        if (TOLDS) { if (SCALE) { const float wg = wgt[j]; pk.x = pk2(o[0] * wg, o[1] * wg); pk.y = pk2(o[2] * wg, o[3] * wg); pk.z = pk2(o[4] * wg, o[5] * wg); pk.w = pk2(o[6] * wg, o[7] * wg); }
            *(LAS v4u*)(ldst + j * lstride) = pk; }
    }
}

constexpr int SSD_DTS = 0, SSD_CUM = 2048, SSD_WGT = 4096, SSD_SSQ = 6144, SSD_BM = 8192, SSD_BST = 272, SSD_CM = SSD_BM + 64 * SSD_BST, SSD_XS = SSD_CM + 64 * SSD_BST, SSD_XST = 1040;
__device__ __forceinline__ float ssd_dt_cum(Frame& F, int tok0, int ntok, int g, bool want_wgt) {
    LAS float* DTS = (LAS float*)(F.lds + SSD_DTS); LAS float* CUM = (LAS float*)(F.lds + SSD_CUM); LAS float* WGT = (LAS float*)(F.lds + SSD_WGT);
    const float* DT = WSP(float, WS_DT);
    { const int s = F.tid >> 3, r = F.tid & 7; DTS[r * 64 + s] = s < ntok ? DT[(size_t)(tok0 + s) * 64 + g * 8 + r] : 0.f; }
    __syncthreads();
    const int r = F.wave, lane = F.lane;
    const float dtv = DTS[r * 64 + lane], av = -__expf(F.b_a_log[g * 8 + r]);
    float x = dtv * av;
#pragma unroll
    for (int o = 1; o < 64; o <<= 1) { const float y = __shfl_up(x, o); if (lane >= o) x += y; }
    const float tot = __shfl(x, 63);
    CUM[r * 64 + lane] = x;
    if (want_wgt) WGT[r * 64 + lane] = __expf(tot - x) * dtv;
    return __expf(tot);
}
__device__ __forceinline__ void ssd_states_phase(Frame& F) {
    LAS unsigned char* L = F.lds; LAS float* WGT = (LAS float*)(L + SSD_WGT);
    const bf16* XBCr = WSP(bf16, WS_XBC); bf16* XCw = WSP(bf16, WS_XC); bf16* ST = WSP(bf16, WS_ST); float* CD = WSP(float, WS_CD);
    const int tid0 = F.tid, r = F.wave;
    for (int u = blockIdx.x; u < 288 * 8; u += F.G) {
        int tid = tid0; asm volatile("" : "+v"(tid));
        const int lane = tid & 63, l15 = lane & 15, g4 = lane >> 4, q = (lane & 15) >> 2, p = lane & 3;
        const int c = u >> 3, g = u & 7; const bool smp = c >= 256; const int tok0 = smp ? SEQ + (c - 256) * 16 : c * 64, ntok = smp ? 16 : 64, h = g * 8 + r;
        const float dec = ssd_dt_cum(F, tok0, ntok, g, true);
        if (!smp && lane == 0) CD[c * 64 + h] = dec;
        __syncthreads();
        const int hk = smp ? 2 : (c == 0 ? 0 : 1); const float* hist = F.state_conv + (size_t)(smp ? c - 256 : 0) * 3 * B_CD;
        { const int tg = tid >> 6, oct = tid & 63; LAS unsigned char* ld = L + SSD_XS + (8 * tg) * SSD_XST + oct * 16;
          if (8 * tg < ntok) conv_item<true, true>(F, XBCr, XCw, g * 512 + oct * 8, tok0 + 8 * tg, tg == 0 ? hk : 1, hist, ld, SSD_XST, WGT + (oct >> 3) * 64 + 8 * tg);
          else {
#pragma unroll
              for (int j = 0; j < 8; ++j) *(LAS v4u*)(ld + j * SSD_XST) = (v4u){0u, 0u, 0u, 0u}; } }
        { const bool isC = tid >= 256; const int t2 = tid & 255, tg = t2 >> 4, oct = t2 & 15; LAS unsigned char* ld = L + SSD_BM + (4 * tg) * SSD_BST + oct * 16;
          if (4 * tg < ntok) { if (isC) conv_item<false, false, 4>(F, XBCr, XCw, 5120 + g * 128 + oct * 8, tok0 + 4 * tg, tg == 0 ? hk : 1, hist, ld, SSD_BST, WGT);
                               else conv_item<false, true, 4>(F, XBCr, XCw, 4096 + g * 128 + oct * 8, tok0 + 4 * tg, tg == 0 ? hk : 1, hist, ld, SSD_BST, WGT); }
          else if (!isC) {
#pragma unroll
              for (int j = 0; j < 4; ++j) *(LAS v4u*)(ld + j * SSD_BST) = (v4u){0u, 0u, 0u, 0u}; } }
        __syncthreads();
#pragma unroll 1
        for (int nh = 0; nh < 2; ++nh) {
            f32x4 acc[4][4];
#pragma unroll
            for (int a = 0; a < 4; ++a)
#pragma unroll
                for (int b = 0; b < 4; ++b) acc[a][b] = (f32x4){0.f, 0.f, 0.f, 0.f};
#pragma unroll
            for (int ks = 0; ks < 2; ++ks) {
                bf16x8 af[4], bfr[4];
                unsigned aa[4], ab[4];
#pragma unroll
                for (int nt = 0; nt < 4; ++nt) aa[nt] = F.lds0 + SSD_BM + (32 * ks + 8 * g4 + q) * SSD_BST + (64 * nh + 16 * nt + 4 * p) * 2;
#pragma unroll
                for (int pt = 0; pt < 4; ++pt) ab[pt] = F.lds0 + SSD_XS + (32 * ks + 8 * g4 + q) * SSD_XST + (r * 64 + 16 * pt + 4 * p) * 2;
                tr_read_x4(aa, 4 * SSD_BST, af); tr_read_x4(ab, 4 * SSD_XST, bfr);
#pragma unroll
                for (int nt = 0; nt < 4; ++nt)
#pragma unroll
                    for (int pt = 0; pt < 4; ++pt) acc[nt][pt] = MFMA16(af[nt], bfr[pt], acc[nt][pt]);
            }
#pragma unroll
            for (int nt = 0; nt < 4; ++nt)
#pragma unroll
                for (int pt = 0; pt < 4; ++pt) { const int n = 64 * nh + 16 * nt + 4 * g4, pp = 16 * pt + l15; const f32x4 a = acc[nt][pt];
                    if (!smp) { v2u o; o.x = pk2(a.x, a.y); o.y = pk2(a.z, a.w); *(v2u*)(ST + (((size_t)c * 64 + h) * 64 + pp) * 128 + n) = o; }
                    else { const size_t idx = (((size_t)(c - 256) * 64 + h) * 64 + pp) * 128 + n; const f32x4 s0 = *(const f32x4*)(F.state_ssm + idx); *(f32x4*)(F.out + O_SSMS + idx) = s0 * dec + a; } }
        }
        __syncthreads();
    }
}
__device__ __forceinline__ void ssd_scan_phase(Frame& F, bool dry) {
    bf16* ST = WSP(bf16, WS_ST); const float* CD = WSP(float, WS_CD); bf16* DS = dry ? WSP(bf16, WS_DUMMY) : ST; const int cmask = dry ? 127 : 255;
    for (int i4 = blockIdx.x * NTHREADS + F.tid; i4 < 64 * 64 * 128 / 4; i4 += F.G * NTHREADS) {
        const int h = i4 >> 11; bf16* p = ST + (size_t)i4 * 4; bf16* pd = DS + (size_t)i4 * 4; float r0 = 0.f, r1 = 0.f, r2 = 0.f, r3 = 0.f;
#pragma unroll 1
        for (int c0 = 0; c0 < 256; c0 += 8) {
            v2u loc[8]; float dc[8];
#pragma unroll
            for (int i = 0; i < 8; ++i) { loc[i] = *(const v2u*)(p + (size_t)(c0 + i) * 524288); dc[i] = CD[(c0 + i) * 64 + h]; }
#pragma unroll
            for (int i = 0; i < 8; ++i) { v2u o; o.x = pk2(r0, r1); o.y = pk2(r2, r3); *(v2u*)(pd + (size_t)((c0 + i) & cmask) * 524288) = o;
                r0 = r0 * dc[i] + bflo(loc[i].x); r1 = r1 * dc[i] + bfhi(loc[i].x); r2 = r2 * dc[i] + bflo(loc[i].y); r3 = r3 * dc[i] + bfhi(loc[i].y); }
        }
        if (!dry) *(f32x4*)(F.out + O_SSMP + (size_t)i4 * 4) = (f32x4){r0, r1, r2, r3};
    }
}
__device__ __forceinline__ void ssd_out_phase(Frame& F, bf16* Ydst) {
    LAS unsigned char* L = F.lds; LAS float* CUM = (LAS float*)(L + SSD_CUM); LAS float* DTS = (LAS float*)(L + SSD_DTS); LAS float* SSQ = (LAS float*)(L + SSD_SSQ);
    const bf16* XC = WSP(bf16, WS_XC); const bf16* ST = WSP(bf16, WS_ST); bf16* ZS = WSP(bf16, WS_ZS);
    const int tid0 = F.tid, r = F.wave;
    for (int u = blockIdx.x; u < 288 * 8; u += F.G) {
        int tid = tid0; asm volatile("" : "+v"(tid));
        const int lane = tid & 63, l15 = lane & 15, g4 = lane >> 4, q = (lane & 15) >> 2, p = lane & 3;
        const int c = u >> 3, g = u & 7; const bool smp = c >= 256; const int tok0 = smp ? SEQ + (c - 256) * 16 : c * 64, ntok = smp ? 16 : 64, h = g * 8 + r;
        (void)ssd_dt_cum(F, tok0, ntok, g, false);
#pragma unroll
        for (int i = 0; i < 2; ++i) { const int idx = tid + i * NTHREADS, s = idx >> 4, c8 = (idx & 15) * 8; v4u vb = (v4u){0u, 0u, 0u, 0u}, vc = vb;
            if (s < ntok) { const bf16* rp = XC + (size_t)(tok0 + s) * B_CD + 4096 + g * 128 + c8; vb = *(const v4u*)rp; vc = *(const v4u*)(rp + 1024); }
            *(LAS v4u*)(L + SSD_BM + s * SSD_BST + c8 * 2) = vb; *(LAS v4u*)(L + SSD_CM + s * SSD_BST + c8 * 2) = vc; }
#pragma unroll
        for (int i = 0; i < 8; ++i) { const int idx = tid + i * NTHREADS, s = idx >> 6, c8 = (idx & 63) * 8; v4u v = (v4u){0u, 0u, 0u, 0u};
            if (s < ntok) v = *(const v4u*)(XC + (size_t)(tok0 + s) * B_CD + g * 512 + c8);
            *(LAS v4u*)(L + SSD_XS + s * SSD_XST + c8 * 2) = v; }
        __syncthreads();
        v2u zq[4][4];
#pragma unroll
        for (int tb = 0; tb < 4; ++tb)
#pragma unroll
            for (int pt = 0; pt < 4; ++pt) { const int t = 16 * tb + l15; zq[tb][pt] = (v2u){0u, 0u}; if (t < ntok) zq[tb][pt] = *(const v2u*)(ZS + (size_t)(tok0 + t) * B_DI + h * 64 + 16 * pt + 4 * g4); }
        f32x4 acc[4][4];
#pragma unroll
        for (int a = 0; a < 4; ++a)
#pragma unroll
            for (int b = 0; b < 4; ++b) acc[a][b] = (f32x4){0.f, 0.f, 0.f, 0.f};
#pragma unroll
        for (int ks = 0; ks < 4; ++ks) {
            bf16x8 af[4], bfr[4];
#pragma unroll
            for (int pt = 0; pt < 4; ++pt) { const int pp = 16 * pt + l15, n0 = 32 * ks + 8 * g4;
                if (!smp) af[pt] = *(const bf16x8*)(ST + (((size_t)c * 64 + h) * 64 + pp) * 128 + n0);
                else { const float* sp = F.state_ssm + (((size_t)(c - 256) * 64 + h) * 64 + pp) * 128 + n0; const f32x4 a = *(const f32x4*)sp, b = *(const f32x4*)(sp + 4);
                    v4u w; w.x = pk2(a.x, a.y); w.y = pk2(a.z, a.w); w.z = pk2(b.x, b.y); w.w = pk2(b.z, b.w); af[pt] = __builtin_bit_cast(bf16x8, w); } }
#pragma unroll
            for (int tb = 0; tb < 4; ++tb) bfr[tb] = *(const LAS bf16x8*)(L + SSD_CM + (16 * tb + l15) * SSD_BST + (32 * ks + 8 * g4) * 2);
#pragma unroll
            for (int pt = 0; pt < 4; ++pt)
#pragma unroll
                for (int tb = 0; tb < 4; ++tb) acc[pt][tb] = MFMA16(af[pt], bfr[tb], acc[pt][tb]);
        }
        float cumt[4];
#pragma unroll
        for (int tb = 0; tb < 4; ++tb) { cumt[tb] = CUM[r * 64 + 16 * tb + l15]; const float e = __expf(cumt[tb]);
#pragma unroll
            for (int pt = 0; pt < 4; ++pt) acc[pt][tb] = acc[pt][tb] * e; }
#pragma unroll
        for (int kk = 0; kk < 2; ++kk) {
            f32x4 gacc[2][4];
#pragma unroll
            for (int a = 0; a < 2; ++a)
#pragma unroll
                for (int b = 0; b < 4; ++b) gacc[a][b] = (f32x4){0.f, 0.f, 0.f, 0.f};
#pragma unroll
            for (int ks = 0; ks < 4; ++ks) {
                bf16x8 af[2], bfr[4];
#pragma unroll
                for (int a = 0; a < 2; ++a) af[a] = *(const LAS bf16x8*)(L + SSD_BM + (16 * (2 * kk + a) + l15) * SSD_BST + (32 * ks + 8 * g4) * 2);
#pragma unroll
                for (int tb = 0; tb < 4; ++tb) bfr[tb] = *(const LAS bf16x8*)(L + SSD_CM + (16 * tb + l15) * SSD_BST + (32 * ks + 8 * g4) * 2);
#pragma unroll
                for (int a = 0; a < 2; ++a)
#pragma unroll
                    for (int tb = 0; tb < 4; ++tb) if (2 * kk + a <= tb) gacc[a][tb] = MFMA16(af[a], bfr[tb], gacc[a][tb]);
            }
            float cs[2][4], ds[2][4];
#pragma unroll
            for (int a = 0; a < 2; ++a)
#pragma unroll
                for (int e = 0; e < 4; ++e) { const int s = 16 * (2 * kk + a) + 4 * g4 + e; cs[a][e] = CUM[r * 64 + s]; ds[a][e] = DTS[r * 64 + s]; }
            bf16x8 lf[4];
#pragma unroll
            for (int tb = 0; tb < 4; ++tb) { const int t = 16 * tb + l15; float w[8];
#pragma unroll
                for (int a = 0; a < 2; ++a)
#pragma unroll
                    for (int e = 0; e < 4; ++e) { const int s = 16 * (2 * kk + a) + 4 * g4 + e; if (2 * kk + a > tb) { w[a * 4 + e] = 0.f; } else { const float arg = s <= t ? cumt[tb] - cs[a][e] : -1e30f; w[a * 4 + e] = gacc[a][tb][e] * __expf(arg) * ds[a][e]; } }
                v4u pkd; pkd.x = pk2(w[0], w[1]); pkd.y = pk2(w[2], w[3]); pkd.z = pk2(w[4], w[5]); pkd.w = pk2(w[6], w[7]); lf[tb] = __builtin_bit_cast(bf16x8, pkd); }
            bf16x8 xf[4]; unsigned ax[4];
#pragma unroll
            for (int pt = 0; pt < 4; ++pt) ax[pt] = F.lds0 + SSD_XS + (32 * kk + 4 * g4 + q) * SSD_XST + (r * 64 + 16 * pt + 4 * p) * 2;
            tr_read_x4(ax, 16 * SSD_XST, xf);
#pragma unroll
            for (int pt = 0; pt < 4; ++pt)
#pragma unroll
                for (int tb = 0; tb < 4; ++tb) if (tb >= 2 * kk) acc[pt][tb] = MFMA16(xf[pt], lf[tb], acc[pt][tb]);
        }
        const float dsk = F.b_d[h];
        float ssq[4];
#pragma unroll
        for (int tb = 0; tb < 4; ++tb) { const int t = 16 * tb + l15; ssq[tb] = 0.f;
#pragma unroll
            for (int pt = 0; pt < 4; ++pt) { const int pp = 16 * pt + 4 * g4; const v2u xx = *(const LAS v2u*)(L + SSD_XS + t * SSD_XST + (r * 64 + pp) * 2);
                const v2u zz = zq[tb][pt];
                f32x4 y = acc[pt][tb];
                y.x = (y.x + dsk * bflo(xx.x)) * silu_f(bflo(zz.x)); y.y = (y.y + dsk * bfhi(xx.x)) * silu_f(bfhi(zz.x)); y.z = (y.z + dsk * bflo(xx.y)) * silu_f(bflo(zz.y)); y.w = (y.w + dsk * bfhi(xx.y)) * silu_f(bfhi(zz.y));
                acc[pt][tb] = y; ssq[tb] += (y.x * y.x + y.y * y.y) + (y.z * y.z + y.w * y.w); }
            ssq[tb] += __shfl_xor(ssq[tb], 16); ssq[tb] += __shfl_xor(ssq[tb], 32);
            if (g4 == 0) SSQ[r * 64 + t] = ssq[tb]; }
        __syncthreads();
#pragma unroll
        for (int tb = 0; tb < 4; ++tb) { const int t = 16 * tb + l15; float tot = 0.f;
#pragma unroll
            for (int rr = 0; rr < 8; ++rr) tot += SSQ[rr * 64 + t];
            const float rstd = 1.0f / sqrtf(tot * (1.f / 512.f) + EPS);
            if (t < ntok) {
#pragma unroll
                for (int pt = 0; pt < 4; ++pt) { const int pp = 16 * pt + 4 * g4; const f32x4 nw = *(const f32x4*)(F.b_norm_w + h * 64 + pp); const f32x4 y = acc[pt][tb] * rstd * nw;
                    v2u o; o.x = pk2(y.x, y.y); o.y = pk2(y.z, y.w); *(v2u*)(Ydst + (size_t)(tok0 + t) * B_DI + h * 64 + pp) = o; } } }
        __syncthreads();
    }
}

constexpr float ATT_THR = -36.0f;
__device__ __forceinline__ void attn_phase(Frame& F, bf16* OZ) {
    constexpr int QS = 0, KS = 34816, VS = 52224, FL = 69632, ST_ = 272;
    LAS unsigned char* L = F.lds; LAS unsigned* flags = (LAS unsigned*)(L + FL);
    const bf16* Qb = WSP(bf16, WS_Q); const bf16* Kb = WSP(bf16, WS_K); const bf16* Vb = WSP(bf16, WS_V); const bf16* CZ = WSP(bf16, WS_CZ);
    const int tid = F.tid, lane = F.lane, wave = F.wave, l15 = lane & 15, g4 = lane >> 4, q = (lane & 15) >> 2, p = lane & 3;
    for (int u = blockIdx.x; u < 2048 + 512; u += F.G) {
        const bool smp = u >= 2048; const int us = u - 2048;
        const int h = smp ? (us & 15) : (u & 15), qb = u >> 4, b = us >> 4;
        const int qrow0 = smp ? SEQ + b * 16 : qb * 128, nq = smp ? 16 : 128;
#pragma unroll
        for (int i = 0; i < 4; ++i) { const int idx = tid + i * NTHREADS, t = idx >> 4, c8 = (idx & 15) * 8; v4u v = (v4u){0u, 0u, 0u, 0u};
            if (t < nq) v = *(const v4u*)(Qb + (size_t)(qrow0 + t) * D + h * 128 + c8);
            *(LAS v4u*)(L + QS + t * ST_ + c8 * 2) = v; }
        __syncthreads();
        const bool active = wave * 16 < nq;
        bf16x8 qf[4];
#pragma unroll
        for (int ks = 0; ks < 4; ++ks) qf[ks] = *(const LAS bf16x8*)(L + QS + (wave * 16 + l15) * ST_ + (32 * ks + 8 * g4) * 2);
        f32x4 oacc[8];
#pragma unroll
        for (int i = 0; i < 8; ++i) oacc[i] = (f32x4){0.f, 0.f, 0.f, 0.f};
        float carry = 0.f;
        const int tq = wave * 16 + l15, tpos = smp ? 1024 + tq : qrow0 + tq;
        const int nkb = smp ? 17 : 2 * qb + 2;
        for (int kb = 0; kb < nkb; ++kb) {
            int spos0, nvalid = 64;
            if (!smp) { spos0 = (2 * qb + 1 - kb) * 64;
#pragma unroll
                for (int i = 0; i < 2; ++i) { const int idx = tid + i * NTHREADS, s = idx >> 4, c8 = (idx & 15) * 8; const size_t off = (size_t)(spos0 + s) * D + h * 128 + c8;
                    *(LAS v4u*)(L + KS + s * ST_ + c8 * 2) = *(const v4u*)(Kb + off); *(LAS v4u*)(L + VS + s * ST_ + c8 * 2) = *(const v4u*)(Vb + off); }
            } else if (kb == 0) { spos0 = 1024; nvalid = 16;
#pragma unroll
                for (int i = 0; i < 2; ++i) { const int idx = tid + i * NTHREADS, s = idx >> 4, c8 = (idx & 15) * 8; v4u vk = (v4u){0u, 0u, 0u, 0u}, vv = vk;
                    if (s < 16) { const size_t off = (size_t)(qrow0 + s) * D + h * 128 + c8; vk = *(const v4u*)(Kb + off); vv = *(const v4u*)(Vb + off); }
                    *(LAS v4u*)(L + KS + s * ST_ + c8 * 2) = vk; *(LAS v4u*)(L + VS + s * ST_ + c8 * 2) = vv; }
            } else { spos0 = 1024 - 64 * kb;
#pragma unroll
                for (int i = 0; i < 2; ++i) { const int idx = tid + i * NTHREADS, s = idx >> 4, c8 = (idx & 15) * 8; const size_t off = (((size_t)b * 16 + h) * 1024 + spos0 + s) * 128 + c8;
                    const f32x4 k0 = *(const f32x4*)(F.cache_k + off), k1 = *(const f32x4*)(F.cache_k + off + 4), v0 = *(const f32x4*)(F.cache_v + off), v1 = *(const f32x4*)(F.cache_v + off + 4);
                    v4u vk, vv; vk.x = pk2(k0.x, k0.y); vk.y = pk2(k0.z, k0.w); vk.z = pk2(k1.x, k1.y); vk.w = pk2(k1.z, k1.w); vv.x = pk2(v0.x, v0.y); vv.y = pk2(v0.z, v0.w); vv.z = pk2(v1.x, v1.y); vv.w = pk2(v1.z, v1.w);
                    *(LAS v4u*)(L + KS + s * ST_ + c8 * 2) = vk; *(LAS v4u*)(L + VS + s * ST_ + c8 * 2) = vv; }
            }
            __syncthreads();
            bool done = true;
            const bool none_visible = spos0 > __builtin_amdgcn_readfirstlane(tpos - l15) + 14;
            if (active && none_visible) done = false;
            if (active && !none_visible) {
                f32x4 sc[4];
#pragma unroll
                for (int sb = 0; sb < 4; ++sb) { sc[sb] = (f32x4){0.f, 0.f, 0.f, 0.f};
#pragma unroll
                    for (int ks = 0; ks < 4; ++ks) { const bf16x8 a = *(const LAS bf16x8*)(L + KS + (16 * sb + l15) * ST_ + (32 * ks + 8 * g4) * 2); sc[sb] = MFMA16(a, qf[ks], sc[sb]); } }
                float lk[4][4], tsum[4], above[4], ttot[4];
#pragma unroll
                for (int sb = 0; sb < 4; ++sb) { tsum[sb] = 0.f;
#pragma unroll
                    for (int e = 0; e < 4; ++e) { const int s = 16 * sb + 4 * g4 + e; const float z = sc[sb][e]; const bool vis = (s < nvalid) && (spos0 + s < tpos);
                        const float sp = fmaxf(z, 0.f) + __logf(1.0f + __expf(-fabsf(z)));
                        lk[sb][e] = vis ? -sp : 0.f; sc[sb][e] = vis ? z - sp : -1e30f; tsum[sb] += lk[sb][e]; }
                    const float v1 = __shfl_xor(tsum[sb], 16), v2 = __shfl_xor(tsum[sb], 32), v3 = __shfl_xor(tsum[sb], 48);
                    above[sb] = ((g4 ^ 1) > g4 ? v1 : 0.f) + ((g4 ^ 2) > g4 ? v2 : 0.f) + ((g4 ^ 3) > g4 ? v3 : 0.f);
                    ttot[sb] = (tsum[sb] + v1) + (v2 + v3); }
                float after = carry;
#pragma unroll
                for (int sb = 3; sb >= 0; --sb) { float run = after + above[sb];
#pragma unroll
                    for (int e = 3; e >= 0; --e) { const float w = __expf(sc[sb][e] + run); run += lk[sb][e]; sc[sb][e] = w; }
                    after += ttot[sb]; }
                carry = after;
#pragma unroll
                for (int kk = 0; kk < 2; ++kk) { v4u pkd; pkd.x = pk2(sc[2 * kk][0], sc[2 * kk][1]); pkd.y = pk2(sc[2 * kk][2], sc[2 * kk][3]); pkd.z = pk2(sc[2 * kk + 1][0], sc[2 * kk + 1][1]); pkd.w = pk2(sc[2 * kk + 1][2], sc[2 * kk + 1][3]);
                    const bf16x8 pf = __builtin_bit_cast(bf16x8, pkd);
#pragma unroll
                    for (int dh = 0; dh < 2; ++dh) { unsigned aa[4]; bf16x8 vf[4];
#pragma unroll
                        for (int i = 0; i < 4; ++i) aa[i] = F.lds0 + VS + (32 * kk + 4 * g4 + q) * ST_ + (16 * (4 * dh + i) + 4 * p) * 2;
                        tr_read_x4(aa, 16 * ST_, vf);
#pragma unroll
                        for (int i = 0; i < 4; ++i) oacc[4 * dh + i] = MFMA16(vf[i], pf, oacc[4 * dh + i]); } }
                done = __all(carry < ATT_THR);
            }
            if (lane == 0) flags[wave] = done ? 1u : 0u;
            __syncthreads();
            unsigned alld = 1u;
#pragma unroll
            for (int i = 0; i < 8; ++i) alld &= flags[i];
            if (__builtin_amdgcn_readfirstlane(alld)) break;
        }
        if (active) {
            const size_t rb = (size_t)(qrow0 + tq) * D + h * 128 + 4 * g4;
#pragma unroll
            for (int dt = 0; dt < 8; ++dt) { const v2u zz = *(const v2u*)(CZ + rb + 16 * dt); const f32x4 o = oacc[dt]; v2u w; w.x = pk2(o.x * silu_f(bflo(zz.x)), o.y * silu_f(bfhi(zz.x))); w.y = pk2(o.z * silu_f(bflo(zz.y)), o.w * silu_f(bfhi(zz.y))); *(v2u*)(OZ + rb + 16 * dt) = w; }
        }
        __syncthreads();
    }
}

struct Args { const float* in[24]; float* out; unsigned char* ws; int ph_lo, ph_hi; };
__global__ void __launch_bounds__(NTHREADS, 2) mk_fwd(Args args) {
    extern __shared__ __attribute__((aligned(16))) unsigned char lds[];
    Frame F;
    F.lds = (LAS unsigned char*)lds; F.lds0 = (unsigned)(size_t)F.lds;
    F.tid = threadIdx.x; F.lane = F.tid & 63; F.wave = __builtin_amdgcn_readfirstlane(F.tid >> 6); F.G = gridDim.x;
    F.x_prompt = args.in[0]; F.x_sample = args.in[1]; F.state_ssm = args.in[2]; F.state_conv = args.in[3]; F.cache_k = args.in[4]; F.cache_v = args.in[5]; F.norm_w = args.in[6]; F.final_norm_w = args.in[7];
    F.a_w_in = args.in[8]; F.a_ln_g = args.in[9]; F.a_ln_b = args.in[10]; F.a_w_s = args.in[11]; F.a_b_s = args.in[12]; F.a_w_out = args.in[13];
    F.b_w_in = args.in[14]; F.b_conv_w = args.in[15]; F.b_conv_b = args.in[16]; F.b_dt_bias = args.in[17]; F.b_a_log = args.in[18]; F.b_d = args.in[19]; F.b_norm_w = args.in[20]; F.b_w_out = args.in[21];
    F.c_w_in = args.in[22]; F.c_w_out = args.in[23];
    F.out = args.out; F.ws = args.ws;
    volatile LAS unsigned* MISC = (volatile LAS unsigned*)(F.lds + MISC_OFF);
    for (int u = F.tid; u < (LDS_BYTES - LDSCTL_OFF) / 4; u += NTHREADS) ((LAS unsigned*)(F.lds + LDSCTL_OFF))[u] = 0u;
    __syncthreads();
    XcdBarrier bar; bar.bar = (unsigned*)(F.ws + WS_CTL) + CW_BAR; bar.x = 0; bar.st = nullptr;
#if MK_ONE_LAUNCH
    bar = xcd_barrier_post((unsigned*)(F.ws + WS_CTL) + CW_BAR, MISC + 8);
#define GRID_BAR() xcd_barrier(bar)
#else
    (void)MISC;
#define GRID_BAR() do { } while (0)
#endif
    const int lo = args.ph_lo, hi = args.ph_hi;
#define IN(k) (lo <= (k) && (k) < hi)
#define SEAM(k) do { if (IN(k) && IN((k) + 1)) GRID_BAR(); } while (0)
    LAS unsigned char* ring = F.lds;
    if (IN(0)) { PROBE(1, p0_prologue(F)); p0_prologue(F); } SEAM(0);
    if (IN(1)) { pg8::Gemm g{WSP(bf16, WS_H), WSP(bf16, WS_WA_IN), M, 12288, HP}; pg8::StaticOrder S; S.init(M, 12288, F.G, (int)blockIdx.x, D);
        pg8::EpiAIn E{WSP(bf16, WS_U), (size_t)(WS_GV - WS_U) / 2, WSP(float, WS_STATS), F.lds + EPI_LDS_OFF, WSP(float, WS_RSTD)};
        PROBE(9, pg8::gemm_phase<pg8::EpiAIn, pg8::StaticOrder, true, true>(ring, g, S, E));
        PROBE(10, { pg8::EpiNull EN{WSP(float, WS_DUMMY)}; pg8::gemm_phase<pg8::EpiNull, pg8::StaticOrder, true, true>(ring, g, S, EN); });
        PROBE(11, { pg8::EpiNullNoLoad EN{WSP(float, WS_DUMMY)}; pg8::gemm_phase<pg8::EpiNullNoLoad, pg8::StaticOrder, true, true>(ring, g, S, EN); });
        PROBE(12, { pg8::EpiNull EN{WSP(float, WS_DUMMY)}; pg8::SameTileOrder S2; S2.so = S; pg8::gemm_phase<pg8::EpiNull, pg8::SameTileOrder, true, true>(ring, g, S2, EN); });
        pg8::gemm_phase<pg8::EpiAIn, pg8::StaticOrder, true, true>(ring, g, S, E); convert_in_tail<1>(F, (M / 256) * 48); } SEAM(1);
    if (IN(2)) { PROBE(2, gmlp_mix_phase(F, 0, WSP(bf16, WS_DUMMY))); gmlp_mix_phase(F, 0, WSP(bf16, WS_U)); convert_in_tail<4>(F, 132 * 16); } SEAM(2);
    if (IN(3)) { pg8::Gemm g{WSP(bf16, WS_U), WSP(bf16, WS_WA_OUT), M, D, AW}; pg8::OutProjOrder S; S.init(SEQ, NSMP, D, AW, 16, F.G, (int)blockIdx.x);
        PROBE(6, { pg8::EpiResid E2{WSP(bf16, WS_DUMMY), HP, WSP(float, WS_DUMMY) + 16 * 1024 * 1024, F.lds + EPI_LDS_OFF, WSP(float, WS_DUMMY), SEQ, NSMP, AW / 16}; pg8::gemm_phase<pg8::EpiResid, pg8::OutProjOrder, true, true>(ring, g, S, E2); });
        pg8::EpiResid E{WSP(bf16, WS_H), HP, WSP(float, WS_SSQ), F.lds + EPI_LDS_OFF, WSP(float, WS_PART), SEQ, NSMP, AW / 16};
        pg8::gemm_phase<pg8::EpiResid, pg8::OutProjOrder, true, true>(ring, g, S, E); } SEAM(3);
    if (IN(4)) { rstd_phase(F, 16); } SEAM(4);
    if (IN(5)) { pg8::Gemm g{WSP(bf16, WS_H), WSP(bf16, WS_WB_IN), M, B_INP, HP}; pg8::StaticOrder S; S.init(M, B_INP, F.G, (int)blockIdx.x, D);
        pg8::EpiBIn E{WSP(bf16, WS_ZS), WSP(bf16, WS_XBC), WSP(float, WS_DT), F.b_dt_bias, F.out + O_CONVP, F.out + O_CONVS, WSP(float, WS_RSTD)};
        PROBE(8, pg8::gemm_phase<pg8::EpiBIn, pg8::StaticOrder, true, true>(ring, g, S, E));
        pg8::gemm_phase<pg8::EpiBIn, pg8::StaticOrder, true, true>(ring, g, S, E); convert_in_tail<2>(F, (M / 256) * 41); } SEAM(5);
    if (IN(7)) { PROBE(3, ssd_states_phase(F)); ssd_states_phase(F); } SEAM(7);
    if (IN(8)) { PROBE(7, ssd_scan_phase(F, true)); ssd_scan_phase(F, false); } SEAM(8);
    if (IN(9)) { PROBE(4, ssd_out_phase(F, WSP(bf16, WS_DUMMY))); ssd_out_phase(F, WSP(bf16, WS_ZS)); } SEAM(9);
    if (IN(10)) { pg8::Gemm g{WSP(bf16, WS_ZS), WSP(bf16, WS_WB_OUT), M, D, B_DI}; pg8::OutProjOrder S; S.init(SEQ, NSMP, D, B_DI, 16, F.G, (int)blockIdx.x);
        pg8::EpiResid E{WSP(bf16, WS_H), HP, WSP(float, WS_SSQ), F.lds + EPI_LDS_OFF, WSP(float, WS_PART), SEQ, NSMP, B_DI / 16};
        pg8::gemm_phase<pg8::EpiResid, pg8::OutProjOrder, true, true>(ring, g, S, E); } SEAM(10);
    if (IN(11)) { rstd_phase(F, 16); } SEAM(11);
    if (IN(12)) { pg8::Gemm g{WSP(bf16, WS_H), WSP(bf16, WS_WC_IN), M, 8192, HP}; pg8::StaticOrder S; S.init(M, 8192, F.G, (int)blockIdx.x, D);
        pg8::EpiCIn E{WSP(bf16, WS_Q), (size_t)(WS_K - WS_Q) / 2, F.out + O_KP, F.out + O_KS, O_VP - O_KP, O_VS - O_KS, WSP(float, WS_RSTD)};
        PROBE(8, pg8::gemm_phase<pg8::EpiCIn, pg8::StaticOrder, true, true>(ring, g, S, E));
        pg8::gemm_phase<pg8::EpiCIn, pg8::StaticOrder, true, true>(ring, g, S, E); convert_in_tail<3>(F, (M / 256) * 32); } SEAM(12);
    if (IN(13)) { PROBE(5, attn_phase(F, WSP(bf16, WS_DUMMY))); attn_phase(F, WSP(bf16, WS_Q)); } SEAM(13);
    if (IN(14)) { pg8::Gemm g{WSP(bf16, WS_Q), WSP(bf16, WS_WC_OUT), M, D, D}; pg8::OutProjOrder S; S.init(SEQ, NSMP, D, D, 8, F.G, (int)blockIdx.x);
        pg8::EpiResid E{WSP(bf16, WS_H), HP, WSP(float, WS_SSQ), F.lds + EPI_LDS_OFF, WSP(float, WS_PART), SEQ, NSMP, D / 8};
        pg8::gemm_phase<pg8::EpiResid, pg8::OutProjOrder, true, true>(ring, g, S, E); } SEAM(14);
    if (IN(15)) { rstd_phase(F, 8); } SEAM(15);
    if (IN(16)) { pg8::Gemm g{WSP(bf16, WS_H), WSP(bf16, WS_WA_IN + WA_IN_BYTES), M, 12288, HP}; pg8::StaticOrder S; S.init(M, 12288, F.G, (int)blockIdx.x, D);
        pg8::EpiAIn E{WSP(bf16, WS_U), (size_t)(WS_GV - WS_U) / 2, WSP(float, WS_STATS), F.lds + EPI_LDS_OFF, WSP(float, WS_RSTD)};
        pg8::gemm_phase<pg8::EpiAIn, pg8::StaticOrder, true, true>(ring, g, S, E); } SEAM(16);
    if (IN(17)) { gmlp_mix_phase(F, 1, WSP(bf16, WS_U)); } SEAM(17);
    if (IN(18)) { pg8::Gemm g{WSP(bf16, WS_U), WSP(bf16, WS_WA_OUT + 16 * MiB), M, D, AW}; pg8::OutProjOrder S; S.init(SEQ, NSMP, D, AW, 16, F.G, (int)blockIdx.x);
        pg8::EpiResid E{WSP(bf16, WS_H), HP, WSP(float, WS_SSQ), F.lds + EPI_LDS_OFF, WSP(float, WS_PART), SEQ, NSMP, AW / 16};
        pg8::gemm_phase<pg8::EpiResid, pg8::OutProjOrder, true, true>(ring, g, S, E); } SEAM(18);
    if (IN(19)) { final_phase(F, 16); }
#undef IN
#undef SEAM
}

extern "C" void kernel_launch(void* const* d_in, const int* in_sizes, int n_in, void* d_out, int out_size, void* d_ws, size_t ws_size, hipStream_t stream) {
    static int grid = 0;
    if (grid == 0) {
        if (n_in != 24 || (size_t)out_size != O_END || ws_size < WS_END) { fprintf(stderr, "kernel_launch: unexpected shapes (n_in %d, out %d, ws %zu < %zu?)\n", n_in, out_size, ws_size, (size_t)WS_END); grid = -1; return; }
        int dev = 0, cus = 0;
        if (hipGetDevice(&dev) != hipSuccess || hipDeviceGetAttribute(&cus, hipDeviceAttributeMultiprocessorCount, dev) != hipSuccess) { grid = -1; return; }
        if (hipFuncSetAttribute((const void*)mk_fwd, hipFuncAttributeMaxDynamicSharedMemorySize, LDS_BYTES) != hipSuccess) { fprintf(stderr, "kernel_launch: hipFuncSetAttribute failed\n"); grid = -1; return; }
        int per_cu = 0;
        if (hipOccupancyMaxActiveBlocksPerMultiprocessor(&per_cu, (const void*)mk_fwd, NTHREADS, LDS_BYTES) != hipSuccess || per_cu < 1) fprintf(stderr, "kernel_launch: occupancy query says %d\n", per_cu);
        (void)hipGetLastError();
        grid = cus;
    }
    if (grid < 0) return;
    (void)hipMemsetAsync((char*)d_ws + WS_CTL, 0, CTL_ZERO_BYTES, stream);
    Args a{};
    for (int i = 0; i < 24; ++i) a.in[i] = (const float*)d_in[i];
    a.out = (float*)d_out; a.ws = (unsigned char*)d_ws;
#if MK_ONE_LAUNCH
    a.ph_lo = 0; a.ph_hi = NPHASES;
    hipLaunchKernelGGL(mk_fwd, dim3(grid), dim3(NTHREADS), LDS_BYTES, stream, a);
#else
    for (int ph = 0; ph < NPHASES; ++ph) { a.ph_lo = ph; a.ph_hi = ph + 1; hipLaunchKernelGGL(mk_fwd, dim3(grid), dim3(NTHREADS), LDS_BYTES, stream, a); }
#endif
}
```
